# Optimizing an MI355X kernel written in HIP

```python
import math
import jax, jax.numpy as jnp
from jax import lax
import numpy as np

D_MODEL = 1024
BATCH = 4
SEQ = 4096
DEPTH = 2

BRANCH_WIDTH = 512
N_BRANCH = 3
S5_GROUP = 16
S5_GROUPS = BRANCH_WIDTH // S5_GROUP
S5_STATE = 64
S5_DT_MIN = 1e-3
S5_DT_MAX = 1e-1
S5_EIG_MAX = -1e-4
HG_HEADS = 4
HG_DK = 128
HG_DV = BRANCH_WIDTH // HG_HEADS
HG_KEY_WIDTH = HG_HEADS * HG_DK
HG_CHUNK = 64
RG_BLOCKS = 8
RG_BLOCK = BRANCH_WIDTH // RG_BLOCKS
RG_C = 8.0
CONV_WIDTH = 4
D_FF = 2816
EPS = 1e-6
IN_SPLIT_SIZES = (BRANCH_WIDTH, HG_KEY_WIDTH, HG_KEY_WIDTH, BRANCH_WIDTH, BRANCH_WIDTH, BRANCH_WIDTH, BRANCH_WIDTH)
IN_TOTAL = BRANCH_WIDTH + 2 * HG_KEY_WIDTH + 2 * BRANCH_WIDTH + 2 * BRANCH_WIDTH + N_BRANCH * D_MODEL

kernel_name = 'hybrid_s5_hgrn2_rglru_macaron'


def rms_norm(x, w):
    xf = x.astype(jnp.float32)
    y = xf * lax.rsqrt(jnp.mean(xf * xf, axis=-1, keepdims=True) + EPS)
    return (y * w.astype(jnp.float32)).astype(x.dtype)


def swiglu(h, w_gate, w_up, w_down):
    return (jax.nn.silu(h @ w_gate) * (h @ w_up)) @ w_down


def _complex_affine_combine(e1, e2):
    a1r, a1i, b1r, b1i = e1
    a2r, a2i, b2r, b2i = e2
    return (a2r * a1r - a2i * a1i,
            a2r * a1i + a2i * a1r,
            a2r * b1r - a2i * b1i + b2r,
            a2r * b1i + a2i * b1r + b2i)


def _real_affine_combine(e1, e2):
    a1, b1 = e1
    a2, b2 = e2
    return (a2 * a1, a2 * b1 + b2)


def s5_mixer(u, lam_re, lam_im, log_dt, b_re, b_im, c_re, c_im, d_skip, glu_w, glu_b):
    f32 = jnp.float32
    bsz, seq, _ = u.shape
    uf = u.astype(f32)
    ug = uf.reshape(bsz, seq, S5_GROUPS, S5_GROUP)
    lr = jnp.minimum(lam_re.astype(f32), S5_EIG_MAX)
    li = lam_im.astype(f32)
    dt = jnp.exp(log_dt.astype(f32))[:, None]
    mag = jnp.exp(lr * dt)
    ar = mag * jnp.cos(li * dt)
    ai = mag * jnp.sin(li * dt)
    den = lr * lr + li * li
    fr = ((ar - 1.0) * lr + ai * li) / den
    fi = (ai * lr - (ar - 1.0) * li) / den
    br, bi = b_re.astype(f32), b_im.astype(f32)
    bbr = fr[..., None] * br - fi[..., None] * bi
    bbi = fr[..., None] * bi + fi[..., None] * br
    bu_r = jnp.einsum('blgc,gpc->blgp', ug, bbr)
    bu_i = jnp.einsum('blgc,gpc->blgp', ug, bbi)
    a_r = jnp.broadcast_to(ar, bu_r.shape)
    a_i = jnp.broadcast_to(ai, bu_i.shape)
    _, _, xr, xi = lax.associative_scan(_complex_affine_combine, (a_r, a_i, bu_r, bu_i), axis=1)
    y = (jnp.einsum('blgp,gcp->blgc', xr, c_re.astype(f32))
         - jnp.einsum('blgp,gcp->blgc', xi, c_im.astype(f32)))
    y = y.reshape(bsz, seq, BRANCH_WIDTH) + d_skip.astype(f32) * uf
    z = jax.nn.gelu(y)
    out = z * jax.nn.sigmoid(z @ glu_w.astype(f32) + glu_b.astype(f32))
    return out.astype(u.dtype)


def hgrn2_mixer(q, z_f, v, g, lb, norm_w):
    f32 = jnp.float32
    bsz, seq, _ = q.shape
    n_chunks = seq // HG_CHUNK
    lb = lb.astype(f32).reshape(HG_HEADS, HG_DK)
    qh = jax.nn.silu(q.astype(f32)).reshape(bsz, seq, HG_HEADS, HG_DK)
    zf = z_f.astype(f32).reshape(bsz, seq, HG_HEADS, HG_DK)
    log_f = jnp.log(lb + (1.0 - lb) * jax.nn.sigmoid(zf))
    kh = (1.0 - lb) * jax.nn.sigmoid(-zf)
    vh = v.astype(f32).reshape(bsz, seq, HG_HEADS, HG_DV)

    def to_chunks(t):
        return t.reshape(bsz, n_chunks, HG_CHUNK, HG_HEADS, t.shape[-1]).transpose(1, 0, 3, 2, 4)

    causal = jnp.tril(jnp.ones((HG_CHUNK, HG_CHUNK), dtype=bool))[:, :, None]

    def chunk_step(state, inp):
        qc, kc, vc, lfc = inp
        b = jnp.cumsum(lfc, axis=2)
        o_inter = jnp.einsum('bhcd,bhde->bhce', qc * jnp.exp(b), state)
        diff = b[:, :, :, None, :] - b[:, :, None, :, :]
        decay = jnp.where(causal, jnp.exp(jnp.where(causal, diff, 0.0)), 0.0)
        scores = jnp.einsum('bhtd,bhtsd,bhsd->bhts', qc, decay, kc)
        o_intra = jnp.einsum('bhts,bhse->bhte', scores, vc)
        b_last = b[:, :, -1:, :]
        new_state = (jnp.exp(b_last[:, :, 0, :])[..., None] * state
                     + jnp.einsum('bhsd,bhse->bhde', kc * jnp.exp(b_last - b), vc))
        return new_state, o_inter + o_intra

    s0 = jnp.zeros((bsz, HG_HEADS, HG_DK, HG_DV), f32)
    _, o = lax.scan(chunk_step, s0, (to_chunks(qh), to_chunks(kh), to_chunks(vh), to_chunks(log_f)))
    o = o.transpose(1, 0, 3, 2, 4).reshape(bsz, seq, HG_HEADS, HG_DV)
    o = o * lax.rsqrt(jnp.mean(o * o, axis=-1, keepdims=True) + EPS)
    o = o * norm_w.astype(f32).reshape(HG_HEADS, HG_DV)
    out = o.reshape(bsz, seq, BRANCH_WIDTH) * jax.nn.silu(g.astype(f32))
    return out.astype(q.dtype)


def rglru_mixer(xb, gate, conv_w, conv_b, wa, ba, wx, bx, lam):
    f32 = jnp.float32
    bsz, seq, _ = xb.shape
    xc = lax.conv_general_dilated(
        xb, conv_w[:, None, :], window_strides=(1,), padding=[(CONV_WIDTH - 1, 0)],
        dimension_numbers=('NWC', 'WIO', 'NWC'), feature_group_count=BRANCH_WIDTH) + conv_b
    xcf = xc.astype(f32)
    xblk = xcf.reshape(bsz, seq, RG_BLOCKS, RG_BLOCK)
    r = jax.nn.sigmoid(jnp.einsum('blhi,hij->blhj', xblk, wa.astype(f32)).reshape(bsz, seq, BRANCH_WIDTH) + ba.astype(f32))
    i = jax.nn.sigmoid(jnp.einsum('blhi,hij->blhj', xblk, wx.astype(f32)).reshape(bsz, seq, BRANCH_WIDTH) + bx.astype(f32))
    log_a = -RG_C * jax.nn.softplus(-lam.astype(f32)) * r
    a = jnp.exp(log_a)
    b = jnp.sqrt(-jnp.expm1(2.0 * log_a)) * (i * xcf)
    _, hseq = lax.associative_scan(_real_affine_combine, (a, b), axis=1)
    return (hseq * jax.nn.gelu(gate.astype(f32))).astype(xb.dtype)


def hybrid_mixer(h, w_in, branch_proj, w_out,
                 s5_lambda_re, s5_lambda_im, s5_log_dt, s5_b_re, s5_b_im, s5_c_re, s5_c_im,
                 s5_d, s5_glu_w, s5_glu_b, hg_lb, hg_norm_w,
                 rg_conv_w, rg_conv_b, rg_wa, rg_ba, rg_wx, rg_bx, rg_lambda):
    bsz, seq, _ = h.shape
    proj = h @ w_in
    points, acc = [], 0
    for s in IN_SPLIT_SIZES:
        acc += s
        points.append(acc)
    u_a, q_b, f_b, v_b, g_b, x_c, gate_c, gate_merge = jnp.split(proj, points, axis=-1)
    y_a = s5_mixer(u_a, s5_lambda_re, s5_lambda_im, s5_log_dt, s5_b_re, s5_b_im,
                   s5_c_re, s5_c_im, s5_d, s5_glu_w, s5_glu_b)
    y_b = hgrn2_mixer(q_b, f_b, v_b, g_b, hg_lb, hg_norm_w)
    y_c = rglru_mixer(x_c, gate_c, rg_conv_w, rg_conv_b, rg_wa, rg_ba, rg_wx, rg_bx, rg_lambda)
    branches = jnp.stack([y_a, y_b, y_c], axis=2)
    up = jnp.einsum('blnw,nwd->blnd', branches, branch_proj)
    gates = jax.nn.sigmoid(gate_merge.astype(jnp.float32)).reshape(bsz, seq, N_BRANCH, D_MODEL)
    merged = jnp.sum(gates * up.astype(jnp.float32), axis=2).astype(h.dtype)
    return merged @ w_out


def setup_inputs(seed: int = 0) -> dict:
    key = jax.random.key(seed)
    ks = jax.random.split(key, 32)
    f32 = jnp.float32

    def nrm(k, shape, scale):
        return jax.random.normal(k, shape, f32) * scale

    x = nrm(ks[0], (BATCH, SEQ, D_MODEL), 1.0)
    norm_w = 1.0 + nrm(ks[1], (DEPTH, 3, D_MODEL), 0.02)
    final_norm_w = 1.0 + nrm(ks[2], (D_MODEL,), 0.02)
    ffn_gate = nrm(ks[3], (DEPTH, 2, D_MODEL, D_FF), D_MODEL ** -0.5)
    ffn_up = nrm(ks[4], (DEPTH, 2, D_MODEL, D_FF), D_MODEL ** -0.5)
    ffn_down = nrm(ks[5], (DEPTH, 2, D_FF, D_MODEL), D_FF ** -0.5)
    w_in = nrm(ks[6], (DEPTH, D_MODEL, IN_TOTAL), D_MODEL ** -0.5)
    branch_proj = nrm(ks[7], (DEPTH, N_BRANCH, BRANCH_WIDTH, D_MODEL), BRANCH_WIDTH ** -0.5)
    w_out = nrm(ks[8], (DEPTH, D_MODEL, D_MODEL), D_MODEL ** -0.5)
    s5_lambda_re = -0.5 + nrm(ks[9], (DEPTH, S5_GROUPS, S5_STATE), 0.01)
    s5_lambda_im = (math.pi * jnp.arange(S5_STATE, dtype=f32)) + nrm(ks[10], (DEPTH, S5_GROUPS, S5_STATE), 0.01)
    s5_log_dt = jax.random.uniform(ks[11], (DEPTH, S5_GROUPS), f32, math.log(S5_DT_MIN), math.log(S5_DT_MAX))
    s5_b_re = nrm(ks[12], (DEPTH, S5_GROUPS, S5_STATE, S5_GROUP), (2.0 * S5_GROUP) ** -0.5)
    s5_b_im = nrm(ks[13], (DEPTH, S5_GROUPS, S5_STATE, S5_GROUP), (2.0 * S5_GROUP) ** -0.5)
    s5_c_re = nrm(ks[14], (DEPTH, S5_GROUPS, S5_GROUP, S5_STATE), S5_STATE ** -0.5)
    s5_c_im = nrm(ks[15], (DEPTH, S5_GROUPS, S5_GROUP, S5_STATE), S5_STATE ** -0.5)
    s5_d = nrm(ks[16], (DEPTH, BRANCH_WIDTH), 1.0)
    s5_glu_w = nrm(ks[17], (DEPTH, BRANCH_WIDTH, BRANCH_WIDTH), BRANCH_WIDTH ** -0.5)
    s5_glu_b = nrm(ks[18], (DEPTH, BRANCH_WIDTH), 0.01)
    hg_lb_logits = 1.0 + nrm(ks[19], (DEPTH, HG_KEY_WIDTH), 0.1)
    hg_norm_w = 1.0 + nrm(ks[20], (DEPTH, BRANCH_WIDTH), 0.02)
    rg_conv_w = nrm(ks[21], (DEPTH, CONV_WIDTH, BRANCH_WIDTH), CONV_WIDTH ** -0.5)
    rg_conv_b = nrm(ks[22], (DEPTH, BRANCH_WIDTH), 0.01)
    rg_wa = nrm(ks[23], (DEPTH, RG_BLOCKS, RG_BLOCK, RG_BLOCK), RG_BLOCK ** -0.5)
    rg_ba = nrm(ks[24], (DEPTH, BRANCH_WIDTH), 0.01)
    rg_wx = nrm(ks[25], (DEPTH, RG_BLOCKS, RG_BLOCK, RG_BLOCK), RG_BLOCK ** -0.5)
    rg_bx = nrm(ks[26], (DEPTH, BRANCH_WIDTH), 0.01)
    a_c = jax.random.uniform(ks[27], (DEPTH, BRANCH_WIDTH), f32, 0.9, 0.999)
    s = a_c ** (1.0 / RG_C)
    rg_lambda = jnp.log(s) - jnp.log1p(-s)
    return {'x': x, 'norm_w': norm_w, 'final_norm_w': final_norm_w,
            'ffn_gate': ffn_gate, 'ffn_up': ffn_up, 'ffn_down': ffn_down,
            'w_in': w_in, 'branch_proj': branch_proj, 'w_out': w_out,
            's5_lambda_re': s5_lambda_re, 's5_lambda_im': s5_lambda_im, 's5_log_dt': s5_log_dt,
            's5_b_re': s5_b_re, 's5_b_im': s5_b_im, 's5_c_re': s5_c_re, 's5_c_im': s5_c_im,
            's5_d': s5_d, 's5_glu_w': s5_glu_w, 's5_glu_b': s5_glu_b,
            'hg_lb_logits': hg_lb_logits, 'hg_norm_w': hg_norm_w,
            'rg_conv_w': rg_conv_w, 'rg_conv_b': rg_conv_b, 'rg_wa': rg_wa, 'rg_ba': rg_ba,
            'rg_wx': rg_wx, 'rg_bx': rg_bx, 'rg_lambda': rg_lambda}


def reference(x, norm_w, final_norm_w, ffn_gate, ffn_up, ffn_down, w_in, branch_proj, w_out,
              s5_lambda_re, s5_lambda_im, s5_log_dt, s5_b_re, s5_b_im, s5_c_re, s5_c_im,
              s5_d, s5_glu_w, s5_glu_b, hg_lb_logits, hg_norm_w,
              rg_conv_w, rg_conv_b, rg_wa, rg_ba, rg_wx, rg_bx, rg_lambda):
    p = jax.nn.softmax(hg_lb_logits.astype(jnp.float32), axis=0)
    lower_bounds = jnp.cumsum(p, axis=0) - p[0]
    for l in range(DEPTH):
        h = rms_norm(x, norm_w[l, 0])
        x = x + 0.5 * swiglu(h, ffn_gate[l, 0], ffn_up[l, 0], ffn_down[l, 0])
        h = rms_norm(x, norm_w[l, 1])
        x = x + hybrid_mixer(h, w_in[l], branch_proj[l], w_out[l],
                             s5_lambda_re[l], s5_lambda_im[l], s5_log_dt[l], s5_b_re[l], s5_b_im[l],
                             s5_c_re[l], s5_c_im[l], s5_d[l], s5_glu_w[l], s5_glu_b[l],
                             lower_bounds[l], hg_norm_w[l],
                             rg_conv_w[l], rg_conv_b[l], rg_wa[l], rg_ba[l], rg_wx[l], rg_bx[l], rg_lambda[l])
        h = rms_norm(x, norm_w[l, 2])
        x = x + 0.5 * swiglu(h, ffn_gate[l, 1], ffn_up[l, 1], ffn_down[l, 1])
    return rms_norm(x, final_norm_w)
```

```cpp
#include <hip/hip_runtime.h>
#include <hip/hip_cooperative_groups.h>
#include <cstdio>
#include <cstdint>
namespace cg = cooperative_groups;
namespace pg8 {
#define PG8_LAS __attribute__((address_space(3)))
typedef unsigned short bf16_t;
typedef short bf16x8 __attribute__((ext_vector_type(8)));
typedef float f32x4 __attribute__((ext_vector_type(4)));
typedef unsigned u32x4 __attribute__((ext_vector_type(4)));
constexpr int BM = 256, BK = 64, HALF = 128, HTB = HALF * BK * 2  , STAGE_BYTES = 8 * HTB, NXCD = 8, WGM = 8;

__host__ __device__ __forceinline__ int lds_byte(int r, int c) { const int st = (r >> 4) * 2 + (c >> 5), rr = r & 15, cc = c & 31, ob = rr * 64 + cc * 2; return st * 1024 + (ob ^ (((ob >> 9) & 1) << 5)); }
__host__ __device__ __forceinline__ void stage_rc(int b, int& R, int& C) { const int st = b / 1024, sb = b % 1024, swz = sb ^ (((sb >> 9) & 1) << 5); R = (st >> 1) * 16 + swz / 64; C = (st & 1) * 32 + (swz % 64) / 2; }
__host__ __device__ __forceinline__ int perm32(int rho) { const int n = rho >> 4, i = rho & 15; return 8 * (i >> 2) + 4 * n + (i & 3); }

struct Unit { int pm, pn, sg; };
struct Gemm { const bf16_t* A; const bf16_t* Bt; int M, N, K, lda; int so0, so1, so2, bseg; };

struct StaticOrder {
    int nM, nN, nwg, G, c, nseg;
    __host__ __device__ void init(int M, int N, int G_, int c_, int nseg_ = 1) { nM = M / BM; nN = N / BM; nwg = nM * nN; G = G_; c = c_; nseg = nseg_; }
    __host__ __device__ bool next(int i, Unit& u) const {
        const int ib = i / nseg; u.sg = i - ib * nseg;
        const long L = (long)ib * G + c; if (L >= nwg) return false;
        int wgid = (int)L; { const int q = nwg / NXCD, r = nwg % NXCD, xcd = wgid % NXCD, off = wgid / NXCD; wgid = (xcd < r ? xcd * (q + 1) : r * (q + 1) + (xcd - r) * q) + off; }
        const int nig = WGM * nN, gid = wgid / nig, fm = gid * WGM, gsz = (nM - fm) < WGM ? (nM - fm) : WGM;
        u.pm = fm + ((wgid % nig) % gsz); u.pn = (wgid % nig) / gsz; return true;
    }
    __device__ __forceinline__ void a_ready(const Unit&) const {}
    __device__ __forceinline__ void done(const Unit&) const {}
};


template <class Epi, class Sched, bool ALIGN_EPI = false, bool SP2 = false>
__device__ __forceinline__ void gemm_phase(PG8_LAS unsigned char* lds, const Gemm g, const Sched& S, const Epi& E, const int tid) {
    const int wid = __builtin_amdgcn_readfirstlane(tid >> 6), lane = tid & 63, wr = wid >> 2, wc = wid & 3, fr = lane & 15, fq = lane >> 4;
    const int K = g.K, nt = K / BK;
    unsigned voffA[2], voffB[2];
#pragma unroll
    for (int i = 0; i < 2; ++i) { int R, C; stage_rc(tid * 16 + i * 8192, R, C); const int Rb = Epi::PERM ? ((R & ~31) + perm32(R & 31)) : R;
        voffA[i] = (unsigned)(R * g.lda + C) * 2u; voffB[i] = (unsigned)(Rb * K + C) * 2u; }
    const size_t kstep = (size_t)(BK * 2);
    const size_t hstepA = (size_t)HALF * g.lda * 2, hstepB = (size_t)HALF * K * 2;
    const size_t tstepA = 2 * hstepA, tstepB = 2 * hstepB;
    const unsigned ldsw = (unsigned)wid * 1024u;
    const int aoff = lds_byte(wr * 64 + fr, fq * 8), boff = lds_byte(wc * 32 + fr, fq * 8);
#define PG8_SA(b, h) (((b) * 2 + (h)) * HTB)
#define PG8_SB(b, h) ((4 + (b) * 2 + (h)) * HTB)
#define PG8_STAGE(bufoff, gbase, voff) do { _Pragma("unroll") for (int _i = 0; _i < 2; ++_i) \
        __builtin_amdgcn_global_load_lds((const unsigned*)((const char*)(gbase) + (voff)[_i]), (PG8_LAS unsigned*)(lds + (bufoff) + ldsw + _i * 8192), 16, 0, 0); } while (0)
#define PG8_LDA(dst, b, h) do { _Pragma("unroll") for (int m = 0; m < 4; ++m) _Pragma("unroll") for (int k = 0; k < 2; ++k) dst[m][k] = *(const PG8_LAS bf16x8*)(lds + PG8_SA(b, h) + aoff + m * 2048 + k * 1024); } while (0)
#define PG8_LDB(dst, b, h) do { _Pragma("unroll") for (int n = 0; n < 2; ++n) _Pragma("unroll") for (int k = 0; k < 2; ++k) dst[n][k] = *(const PG8_LAS bf16x8*)(lds + PG8_SB(b, h) + boff + n * 2048 + k * 1024); } while (0)
#define PG8_MMA(ai, bj, At, Bt) do { __builtin_amdgcn_s_setprio(1); _Pragma("unroll") for (int m = 0; m < 4; ++m) _Pragma("unroll") for (int n = 0; n < 2; ++n) _Pragma("unroll") for (int k = 0; k < 2; ++k) \
        acc[ai][bj][m][n] = __builtin_amdgcn_mfma_f32_16x16x32_bf16(Bt[n][k], At[m][k], acc[ai][bj][m][n], 0, 0, 0); __builtin_amdgcn_s_setprio(0); } while (0)
#define PG8_WAIT_V(n) asm volatile("s_waitcnt vmcnt(" #n ")" ::: "memory")
#define PG8_WAIT_L(n) asm volatile("s_waitcnt lgkmcnt(" #n ")" ::: "memory")
#define PG8_BAR __builtin_amdgcn_s_barrier()
#define PG8_SCHED __builtin_amdgcn_sched_barrier(0)
    Unit cur, nxt; int ui = 0;
    if (!S.next(0, cur)) return;
    f32x4 acc[2][2][4][2];
#pragma unroll
    for (int a = 0; a < 2; ++a)
#pragma unroll
        for (int b = 0; b < 2; ++b)
#pragma unroll
            for (int m = 0; m < 4; ++m)
#pragma unroll
                for (int n = 0; n < 2; ++n) acc[a][b][m][n] = (f32x4){0.f, 0.f, 0.f, 0.f};
    bf16x8 At[4][2], B0[2][2], B1[2][2];
#define PG8_SO(u) ((size_t)((u).sg == 0 ? g.so0 : ((u).sg == 1 ? g.so1 : g.so2)))
    const char* cA = (const char*)g.A + (size_t)cur.pm * tstepA + PG8_SO(cur); const char* cB = (const char*)g.Bt + (size_t)cur.pn * tstepB + (size_t)cur.sg * g.bseg;
    S.a_ready(cur);
    if constexpr (SP2) {
        PG8_STAGE(PG8_SB(0, 0), cB, voffB); PG8_STAGE(PG8_SB(0, 1), cB + hstepB, voffB); PG8_STAGE(PG8_SA(0, 0), cA, voffA); PG8_STAGE(PG8_SA(0, 1), cA + hstepA, voffA);
        if (wr == 1) PG8_BAR;
        PG8_WAIT_V(2); PG8_BAR;
        PG8_STAGE(PG8_SB(1, 0), cB + kstep, voffB); PG8_STAGE(PG8_SA(1, 0), cA + kstep, voffA); PG8_STAGE(PG8_SB(1, 1), cB + hstepB + kstep, voffB);
        PG8_WAIT_V(6); PG8_BAR;
    } else {
        PG8_STAGE(PG8_SB(0, 0), cB, voffB); PG8_STAGE(PG8_SA(0, 0), cA, voffA); PG8_STAGE(PG8_SB(0, 1), cB + hstepB, voffB); PG8_STAGE(PG8_SA(0, 1), cA + hstepA, voffA);
        if (wr == 1) PG8_BAR;
        PG8_WAIT_V(4); PG8_BAR;
        PG8_STAGE(PG8_SB(1, 0), cB + kstep, voffB); PG8_STAGE(PG8_SA(1, 0), cA + kstep, voffA); PG8_STAGE(PG8_SB(1, 1), cB + hstepB + kstep, voffB);
        PG8_WAIT_V(6); PG8_BAR;
    }
    for (;;) {
        const bool has_next = S.next(ui + 1, nxt);
        const char* nA = has_next ? (const char*)g.A + (size_t)nxt.pm * tstepA + PG8_SO(nxt) : cA; const char* nB = has_next ? (const char*)g.Bt + (size_t)nxt.pn * tstepB + (size_t)nxt.sg * g.bseg : cB;
        for (int t = 0; t < nt; t += 2) {
            const bool last = (t == nt - 2);
            const char* a1 = cA + (size_t)(t + 1) * kstep;
            const char* a2 = last ? nA : cA + (size_t)(t + 2) * kstep; const char* b2 = last ? nB : cB + (size_t)(t + 2) * kstep;
            const char* a3 = a2 + kstep; const char* b3 = b2 + kstep;
            if (last && has_next) S.a_ready(nxt);
            if constexpr (SP2) {
            PG8_LDB(B0, 0, 0); PG8_LDB(B1, 0, 1); PG8_SCHED; PG8_LDA(At, 0, 0); PG8_STAGE(PG8_SA(1, 1), a1 + hstepA, voffA);
            PG8_WAIT_V(8); PG8_WAIT_L(0); PG8_BAR; PG8_MMA(0, 0, At, B0); PG8_MMA(0, 1, At, B1); PG8_BAR; PG8_SCHED;
            PG8_LDA(At, 0, 1); PG8_STAGE(PG8_SB(0, 0), b2, voffB); PG8_STAGE(PG8_SB(0, 1), b2 + hstepB, voffB); PG8_STAGE(PG8_SA(0, 0), a2, voffA);
            PG8_WAIT_V(8); PG8_WAIT_L(0); PG8_BAR; PG8_MMA(1, 0, At, B0); PG8_MMA(1, 1, At, B1); PG8_BAR; PG8_SCHED;
            PG8_LDB(B0, 1, 0); PG8_LDB(B1, 1, 1); PG8_SCHED; PG8_LDA(At, 1, 0); PG8_STAGE(PG8_SA(0, 1), a2 + hstepA, voffA);
            PG8_WAIT_V(8); PG8_WAIT_L(0); PG8_BAR; PG8_MMA(0, 0, At, B0); PG8_MMA(0, 1, At, B1); PG8_BAR; PG8_SCHED;
            PG8_LDA(At, 1, 1); PG8_STAGE(PG8_SB(1, 0), b3, voffB); PG8_STAGE(PG8_SB(1, 1), b3 + hstepB, voffB); PG8_STAGE(PG8_SA(1, 0), a3, voffA);
            PG8_WAIT_V(8); PG8_WAIT_L(0); PG8_BAR; PG8_MMA(1, 0, At, B0); PG8_MMA(1, 1, At, B1); PG8_BAR; PG8_SCHED;
            } else {
            PG8_LDB(B0, 0, 0); PG8_SCHED; PG8_LDA(At, 0, 0); PG8_STAGE(PG8_SA(1, 1), a1 + hstepA, voffA);
            PG8_WAIT_L(8); PG8_BAR; PG8_WAIT_L(0); PG8_MMA(0, 0, At, B0); PG8_BAR; PG8_SCHED;
            PG8_LDB(B1, 0, 1); PG8_STAGE(PG8_SB(0, 0), b2, voffB);
            PG8_BAR; PG8_WAIT_L(0); PG8_MMA(0, 1, At, B1); PG8_BAR;
            PG8_LDA(At, 0, 1); PG8_STAGE(PG8_SA(0, 0), a2, voffA);
            PG8_BAR; PG8_WAIT_L(0); PG8_MMA(1, 0, At, B0); PG8_BAR; PG8_SCHED;
            PG8_STAGE(PG8_SB(0, 1), b2 + hstepB, voffB);
            PG8_WAIT_V(6); PG8_BAR; PG8_MMA(1, 1, At, B1); PG8_BAR;
            PG8_LDB(B0, 1, 0); PG8_SCHED; PG8_LDA(At, 1, 0); PG8_STAGE(PG8_SA(0, 1), a2 + hstepA, voffA);
            PG8_WAIT_L(8); PG8_BAR; PG8_WAIT_L(0); PG8_MMA(0, 0, At, B0); PG8_BAR; PG8_SCHED;
            PG8_LDB(B1, 1, 1); PG8_STAGE(PG8_SB(1, 0), b3, voffB);
            PG8_BAR; PG8_WAIT_L(0); PG8_MMA(0, 1, At, B1); PG8_BAR;
            PG8_LDA(At, 1, 1); PG8_STAGE(PG8_SA(1, 0), a3, voffA);
            PG8_BAR; PG8_WAIT_L(0); PG8_MMA(1, 0, At, B0); PG8_BAR; PG8_SCHED;
            PG8_STAGE(PG8_SB(1, 1), b3 + hstepB, voffB);
            PG8_WAIT_V(6); PG8_BAR; PG8_MMA(1, 1, At, B1); PG8_BAR;
            }
        }
        if constexpr (ALIGN_EPI) { if (wr == 0) PG8_BAR; }
        if constexpr (!Epi::AFTER_DRAIN) { E(acc, cur, wr, wc, fr, fq); S.done(cur); }
        if (!has_next) break;
#pragma unroll
        for (int a = 0; a < 2; ++a)
#pragma unroll
            for (int b = 0; b < 2; ++b)
#pragma unroll
                for (int m = 0; m < 4; ++m)
#pragma unroll
                    for (int n = 0; n < 2; ++n) acc[a][b][m][n] = (f32x4){0.f, 0.f, 0.f, 0.f};
        cur = nxt; cA = nA; cB = nB; ++ui;
        if constexpr (ALIGN_EPI) { if (wr == 1) PG8_BAR; }
    }
    PG8_WAIT_V(0);
    if constexpr (!ALIGN_EPI) { if (wr == 0) PG8_BAR; }
    PG8_BAR;
    if constexpr (Epi::AFTER_DRAIN) { E.fused(acc, cur, wr, wc, fr, fq, lds, wid, lane); S.done(cur); }
#undef PG8_SO
#undef PG8_SA
#undef PG8_SB
#undef PG8_STAGE
#undef PG8_LDA
#undef PG8_LDB
#undef PG8_MMA
#undef PG8_WAIT_V
#undef PG8_WAIT_L
#undef PG8_BAR
#undef PG8_SCHED
}
}


typedef unsigned short bf16;
typedef pg8::bf16x8 bf16x8;
typedef pg8::f32x4 f32x4;
typedef pg8::u32x4 u32x4;
typedef unsigned u32x2 __attribute__((ext_vector_type(2)));
typedef float f32x2 __attribute__((ext_vector_type(2)));
constexpr int NTOK = 16384, DM = 1024, DFF = 2816;
constexpr int PW = 3584, GMW = 3072;
constexpr int UA_OFF = 0, Q_OFF = 512, F_OFF = 1024, V_OFF = 1536, G_OFF = 2048, XC_OFF = 2560, GC_OFF = 3072;
constexpr size_t MiB = 1u << 20;
constexpr size_t WS_LB = 0, WS_AR = 8192, WS_AI = 16384, WS_BBT = 65536, WS_CM = 512 * 1024, WS_DEC = 1 * MiB, WS_AGG = 2 * MiB, WS_SLOC = 4 * MiB,
                 WS_W = 8 * MiB, WS_HB = 28 * MiB, WS_PROJ = 60 * MiB, WS_R = 172 * MiB, WS_IX = 188 * MiB, WS_HGS = 204 * MiB, WS_GM = 172 * MiB, WS_ACT = 172 * MiB, WS_WI0 = 260 * MiB, WS_TEAM = 268 * MiB, WS_TEAMX = 268 * MiB + 475136, WS_END = 268 * MiB + 475136 + 1024 + 3456 * 4;
constexpr size_t W_GU = 0, W_D = (size_t)7602176;
constexpr size_t W_GMW = 0, W_BP = (size_t)3072 * 1024, W_WO = W_BP + (size_t)3 * 1024 * 512, W_GLU = W_WO + (size_t)1024 * 1024;
static_assert((W_GLU + 512 * 512) <= W_D && (W_D + (size_t)1024 * 2816) * 2 <= 20 * MiB && (size_t)5632 * 1024 <= W_D, "W region");
constexpr int LDS_PHASE = 143360;
constexpr int LDS_BYTES = LDS_PHASE + 64;
constexpr size_t WS_BAR = 268 * MiB + 475136 + 1024;
constexpr size_t CTL_BYTES = 475136 + 1024 + 3456 * 4;
constexpr int NPH = 29;

typedef __bf16 bf16x2_t __attribute__((ext_vector_type(2)));
__device__ __forceinline__ unsigned pk2(float lo, float hi) { f32x2 v = {lo, hi}; bf16x2_t b = __builtin_convertvector(v, bf16x2_t); return __builtin_bit_cast(unsigned, b); }
__device__ __forceinline__ unsigned f2bf(float f) { return pk2(f, 0.f) & 0xffffu; }
__device__ __forceinline__ float bf2f(unsigned h) { return __builtin_bit_cast(float, h << 16); }
__device__ __forceinline__ float rcp_(float x) { return __builtin_amdgcn_rcpf(x); }
__device__ __forceinline__ float sigm(float x) { return rcp_(1.f + __expf(-x)); }
__device__ __forceinline__ float silu_(float x) { return x * sigm(x); }
__device__ __forceinline__ float gelu_(float x) { return x * sigm(1.5957691216057308f * (x + 0.044715f * x * x * x)); }
__device__ __forceinline__ void load8(const bf16* p, float (&v)[8]) {
    const u32x4 w = *(const u32x4*)p;
#pragma unroll
    for (int i = 0; i < 4; ++i) { v[2 * i] = __builtin_bit_cast(float, w[i] << 16); v[2 * i + 1] = __builtin_bit_cast(float, w[i] & 0xffff0000u); }
}
__device__ __forceinline__ void store8(bf16* p, const float (&v)[8]) {
    u32x4 w; w.x = pk2(v[0], v[1]); w.y = pk2(v[2], v[3]); w.z = pk2(v[4], v[5]); w.w = pk2(v[6], v[7]); *(u32x4*)p = w;
}
__device__ __forceinline__ float wave_sum(float v) {
#pragma unroll
    for (int o = 1; o < 64; o <<= 1) v += __shfl_xor(v, o);
    return v;
}
#define LBAR() do { asm volatile("s_waitcnt lgkmcnt(0)" ::: "memory"); __builtin_amdgcn_s_barrier(); asm volatile("" ::: "memory"); } while (0)
#define MFMA16(a, b, c) __builtin_amdgcn_mfma_f32_16x16x32_bf16((a), (b), (c), 0, 0, 0)

struct Epi {
    static constexpr bool PERM = true, AFTER_DRAIN = false;
    int mode; bf16* O; int ldc; float* X; const float* Xsrc; float scale; const bf16* aux; int ldaux; const float* vec; int first;
    __device__ __forceinline__ void operator()(const f32x4 (&acc)[2][2][4][2], const pg8::Unit& u, int wr, int wc, int fr, int fq) const {
        const int row0 = u.pm * 256 + wr * 64 + fr, cl = wc * 32 + 8 * fq;
        if (mode == 0) {
#pragma unroll
            for (int ai = 0; ai < 2; ++ai)
#pragma unroll
                for (int m = 0; m < 4; ++m) { const int row = row0 + ai * 128 + m * 16; float v[8];
#pragma unroll
                    for (int n = 0; n < 2; ++n)
#pragma unroll
                        for (int j = 0; j < 4; ++j) v[n * 4 + j] = silu_(acc[ai][0][m][n][j]) * acc[ai][1][m][n][j];
                    store8(O + (size_t)row * ldc + u.pn * 128 + cl, v); }
        } else if (mode == 1) {
#pragma unroll
            for (int ai = 0; ai < 2; ++ai)
#pragma unroll
                for (int m = 0; m < 4; ++m) { const int row = row0 + ai * 128 + m * 16;
#pragma unroll
                    for (int bj = 0; bj < 2; ++bj) { const size_t off = (size_t)row * DM + u.pn * 256 + bj * 128 + cl; float* p = X + off; const float* ps = Xsrc + off;
#pragma unroll
                        for (int n = 0; n < 2; ++n) { f32x4 o = *(const f32x4*)(ps + 4 * n); o = o + acc[ai][bj][m][n] * scale; *(f32x4*)(p + 4 * n) = o; } } }
        } else if (mode == 2) {
            const int seg = u.pn >> 1;
#define PROJ_EPI(EXPR) \
            _Pragma("unroll") for (int bj = 0; bj < 2; ++bj) { const int c0 = u.pn * 256 + bj * 128 + cl; \
                _Pragma("unroll") for (int ai = 0; ai < 2; ++ai) _Pragma("unroll") for (int m = 0; m < 4; ++m) { const int row = row0 + ai * 128 + m * 16; float v[8]; \
                    _Pragma("unroll") for (int n = 0; n < 2; ++n) _Pragma("unroll") for (int j = 0; j < 4; ++j) { const float a = acc[ai][bj][m][n][j]; const int i8 = n * 4 + j; (void)i8; v[n * 4 + j] = (EXPR); } \
                    store8(O + (size_t)row * PW + c0, v); } }
            if (seg == 1 || seg == 4) { PROJ_EPI(silu_(a)) }
            else if (seg == 6) { PROJ_EPI(gelu_(a)) }
            else if (seg == 2) {
#pragma unroll
                for (int bj = 0; bj < 2; ++bj) { const int c0 = u.pn * 256 + bj * 128 + cl; float lb[8];
#pragma unroll
                    for (int i = 0; i < 8; ++i) lb[i] = vec[c0 - F_OFF + i];
#pragma unroll
                    for (int ai = 0; ai < 2; ++ai)
#pragma unroll
                        for (int m = 0; m < 4; ++m) { const int row = row0 + ai * 128 + m * 16; float v[8];
#pragma unroll
                            for (int i = 0; i < 8; ++i) { const float a = acc[ai][bj][m][i >> 2][i & 3]; v[i] = __logf(lb[i] + (1.f - lb[i]) * sigm(a)); }
                            store8(O + (size_t)row * PW + c0, v); } }
            } else { PROJ_EPI(a) }
#undef PROJ_EPI
        } else if (mode == 3) {
#pragma unroll
            for (int bj = 0; bj < 2; ++bj) { const int c0 = u.pn * 256 + bj * 128 + cl; float bb[8];
#pragma unroll
                for (int i = 0; i < 8; ++i) bb[i] = vec[c0 + i];
#pragma unroll
                for (int ai = 0; ai < 2; ++ai)
#pragma unroll
                    for (int m = 0; m < 4; ++m) { const int row = row0 + ai * 128 + m * 16; float z[8], v[8]; load8(aux + (size_t)row * ldaux + c0, z);
#pragma unroll
                        for (int n = 0; n < 2; ++n)
#pragma unroll
                            for (int j = 0; j < 4; ++j) v[n * 4 + j] = z[n * 4 + j] * sigm(acc[ai][bj][m][n][j] + bb[n * 4 + j]);
                        store8(O + (size_t)row * ldc + c0, v); } }
        } else if (mode == 4) {
#pragma unroll
            for (int bj = 0; bj < 2; ++bj) { const int c0 = u.pn * 256 + bj * 128 + cl;
#pragma unroll
                for (int ai = 0; ai < 2; ++ai)
#pragma unroll
                    for (int m = 0; m < 4; ++m) { const int row = row0 + ai * 128 + m * 16; float v[8];
#pragma unroll
                        for (int n = 0; n < 2; ++n)
#pragma unroll
                            for (int j = 0; j < 4; ++j) v[n * 4 + j] = sigm(acc[ai][bj][m][n][j]);
                        store8(O + (size_t)row * ldc + c0, v); } }
        } else {
            const bf16* gate = aux + (size_t)u.sg * DM; const int first_ = (u.sg == 0);
#pragma unroll
            for (int bj = 0; bj < 2; ++bj) { const int c0 = u.pn * 256 + bj * 128 + cl;
#pragma unroll
                for (int ai = 0; ai < 2; ++ai)
#pragma unroll
                    for (int m = 0; m < 4; ++m) { const int row = row0 + ai * 128 + m * 16; float gt[8], v[8]; load8(gate + (size_t)row * ldaux + c0, gt);
                        if (first_) {
#pragma unroll
                            for (int i = 0; i < 8; ++i) v[i] = 0.f; } else load8(O + (size_t)row * ldc + c0, v);
#pragma unroll
                        for (int n = 0; n < 2; ++n)
#pragma unroll
                            for (int j = 0; j < 4; ++j) v[n * 4 + j] += gt[n * 4 + j] * acc[ai][bj][m][n][j];
                        store8(O + (size_t)row * ldc + c0, v); } }
        }
    }
};

typedef const __attribute__((address_space(1))) float* inptr_t;
typedef const __attribute__((address_space(4))) inptr_t* KArgP;
struct Ctx {
    KArgP kin; float* X; unsigned char* ws;
    __device__ __forceinline__ const float* in(int k) const { return (const float*)kin[k]; }
    float *LB, *AR, *AI, *DEC, *AGG, *SLOC; bf16 *BBT, *CM, *W, *HB, *PROJ, *R, *IX, *HGS, *GM;
};

__device__ __forceinline__ void norm_rows(const float* src, float* cpy, const float* w, bf16* dst, int gw, int NGW, int mend, int lane) {
    f32x4 wv[4];
#pragma unroll
    for (int j = 0; j < 4; ++j) wv[j] = ((const f32x4*)w)[lane + 64 * j];
    for (int m0 = gw; m0 < mend; m0 += 2 * NGW) {
        const int m1 = (m0 + NGW < mend) ? m0 + NGW : m0;
        const f32x4* xr0 = (const f32x4*)(src + (size_t)m0 * DM) + lane; const f32x4* xr1 = (const f32x4*)(src + (size_t)m1 * DM) + lane; f32x4 v[2][4]; float s0 = 0.f, s1 = 0.f;
#pragma unroll
        for (int j = 0; j < 4; ++j) { v[0][j] = xr0[64 * j]; v[1][j] = xr1[64 * j]; }
#pragma unroll
        for (int j = 0; j < 4; ++j) { s0 += (v[0][j].x * v[0][j].x + v[0][j].y * v[0][j].y) + (v[0][j].z * v[0][j].z + v[0][j].w * v[0][j].w);
                                      s1 += (v[1][j].x * v[1][j].x + v[1][j].y * v[1][j].y) + (v[1][j].z * v[1][j].z + v[1][j].w * v[1][j].w); }
        s0 = wave_sum(s0); s1 = wave_sum(s1);
#pragma unroll
        for (int rr = 0; rr < 2; ++rr) { const int m = rr ? m1 : m0; if (rr && m1 == m0) break; const float rstd = __builtin_amdgcn_rsqf((rr ? s1 : s0) * (1.f / DM) + 1e-6f);
            if (cpy) { f32x4* c = (f32x4*)(cpy + (size_t)m * DM) + lane;
#pragma unroll
                for (int j = 0; j < 4; ++j) c[64 * j] = v[rr][j]; }
            u32x2* o = (u32x2*)(dst + (size_t)m * DM) + lane;
#pragma unroll
            for (int j = 0; j < 4; ++j) { u32x2 pp; pp.x = pk2(v[rr][j].x * rstd * wv[j].x, v[rr][j].y * rstd * wv[j].y); pp.y = pk2(v[rr][j].z * rstd * wv[j].z, v[rr][j].w * rstd * wv[j].w); o[64 * j] = pp; } }
    }
}
__device__ __forceinline__ void final_norm_rows(float* X, const float* w, int gw, int NGW, int mend, int lane) {
    f32x4 wv[4];
#pragma unroll
    for (int j = 0; j < 4; ++j) wv[j] = ((const f32x4*)w)[lane + 64 * j];
    for (int m = gw; m < mend; m += NGW) {
        f32x4* xr = (f32x4*)(X + (size_t)m * DM) + lane; f32x4 v[4]; float s = 0.f;
#pragma unroll
        for (int j = 0; j < 4; ++j) { v[j] = xr[64 * j]; s += (v[j].x * v[j].x + v[j].y * v[j].y) + (v[j].z * v[j].z + v[j].w * v[j].w); }
        s = wave_sum(s); const float rstd = __builtin_amdgcn_rsqf(s * (1.f / DM) + 1e-6f);
#pragma unroll
        for (int j = 0; j < 4; ++j) xr[64 * j] = v[j] * rstd * wv[j];
    }
}
__device__ __forceinline__ void transpose_item(const float* W, int N, bf16* WT, int ldt, int k0, int n0, int dst_row0, float* scr, int lane) {
    float rg_[32];
#pragma unroll
    for (int i = 0; i < 32; ++i) rg_[i] = W[(size_t)(k0 + 2 * i + (lane >> 5)) * N + n0 + (lane & 31)];
#pragma unroll
    for (int i = 0; i < 32; ++i) scr[(2 * i + (lane >> 5)) * 33 + (lane & 31)] = rg_[i];
    asm volatile("s_waitcnt lgkmcnt(0)" ::: "memory");
    const int c = lane & 7;
#pragma unroll
    for (int j = 0; j < 4; ++j) { const int n = (lane >> 3) + 8 * j; const float* s = scr + (8 * c) * 33 + n;
        u32x4 o; o.x = pk2(s[0 * 33], s[1 * 33]); o.y = pk2(s[2 * 33], s[3 * 33]); o.z = pk2(s[4 * 33], s[5 * 33]); o.w = pk2(s[6 * 33], s[7 * 33]);
        *(u32x4*)(WT + (size_t)(dst_row0 + n) * ldt + k0 + 8 * c) = o; }
    asm volatile("s_waitcnt lgkmcnt(0)" ::: "memory");
}
__device__ __forceinline__ void convert_ffn(const Ctx& C, int l, int j, float* scr, int gw, int NGW, int lane, int part) {
    const float* Wg = C.in(3) + (size_t)(l * 2 + j) * DM * DFF; const float* Wu = C.in(4) + (size_t)(l * 2 + j) * DM * DFF; const float* Wd = C.in(5) + (size_t)(l * 2 + j) * DFF * DM;
    for (int it = (part ? 2816 : 0) + gw; it < (part ? 3 * 1408 : 2816); it += NGW) {
        if (it < 2816) { const int up = it >= 1408, r = it - up * 1408, kb = r / 88, nb = r % 88, n0 = 32 * nb;
            transpose_item(up ? Wu : Wg, DFF, C.W + W_GU, DM, 64 * kb, n0, (n0 >> 7) * 256 + (n0 & 127) + up * 128, scr, lane); }
        else { const int r = it - 2816, kb = r >> 5, nb = r & 31; transpose_item(Wd, DM, C.W + W_D, DFF, 64 * kb, 32 * nb, 32 * nb, scr, lane); }
    }
}
__device__ __forceinline__ void convert_mixer(const Ctx& C, int l, float* scr, int gw, int NGW, int lane, int part) {
    if (part == 0) {
        for (int r = gw; r < 1792; r += NGW) { const int kb = r / 112, nb = r % 112; transpose_item(C.in(6) + (size_t)l * DM * 6656, 6656, (bf16*)(C.ws + WS_WI0), DM, 64 * kb, 32 * nb, 32 * nb, scr, lane); }
        return;
    }
    for (int it = gw; it < 1536 + 768 + 512 + 128; it += NGW) {
        int r = it;
        if (r < 1536) { const int kb = r / 96, nb = 112 + r % 96; transpose_item(C.in(6) + (size_t)l * DM * 6656, 6656, C.W + W_GMW, DM, 64 * kb, 32 * nb, 32 * nb - PW, scr, lane); continue; } r -= 1536;
        if (r < 768) { const int n = r >> 8, q = r & 255, kb = q >> 5, nb = q & 31; transpose_item(C.in(7) + (size_t)(l * 3 + n) * 512 * DM, DM, C.W + W_BP + (size_t)n * DM * 512, 512, 64 * kb, 32 * nb, 32 * nb, scr, lane); continue; } r -= 768;
        if (r < 512) { const int kb = r >> 5, nb = r & 31; transpose_item(C.in(8) + (size_t)l * DM * DM, DM, C.W + W_WO, DM, 64 * kb, 32 * nb, 32 * nb, scr, lane); continue; } r -= 512;
        { const int kb = r >> 4, nb = r & 15; transpose_item(C.in(17) + (size_t)l * 512 * 512, 512, C.W + W_GLU, 512, 64 * kb, 32 * nb, 32 * nb, scr, lane); }
    }
}
__device__ __forceinline__ void make_tables(const Ctx& C, int l, int gtid) {
    if (gtid < 2048) {
        const int g = gtid >> 6, p = gtid & 63, gp = (l * 32 + g) * 64 + p;
        const float lr = fminf(C.in(9)[gp], -1e-4f), li = C.in(10)[gp], dt = expf(C.in(11)[l * 32 + g]);
        const float mag = expf(lr * dt); float sn, cs; sincosf(li * dt, &sn, &cs);
        const float ar = mag * cs, ai = mag * sn, den = lr * lr + li * li;
        const float fr = ((ar - 1.0f) * lr + ai * li) / den, fi = (ai * lr - (ar - 1.0f) * li) / den;
        C.AR[gtid] = ar; C.AI[gtid] = ai;
        const float* br = C.in(12) + (size_t)gp * 16; const float* bi = C.in(13) + (size_t)gp * 16;
        bf16* o_re = C.BBT + ((size_t)(g * 128 + p)) * 32; bf16* o_im = C.BBT + ((size_t)(g * 128 + 64 + p)) * 32;
        for (int c = 0; c < 16; ++c) { const float b_r = br[c], b_i = bi[c]; o_re[c] = (bf16)f2bf(fr * b_r - fi * b_i); o_im[c] = (bf16)f2bf(fr * b_i + fi * b_r); }
        { unsigned z = 0u; asm volatile("" : "+v"(z)); const u32x4 zz = {z, z, z, z};
          *(u32x4*)(o_re + 16) = zz; *(u32x4*)(o_re + 24) = zz; *(u32x4*)(o_im + 16) = zz; *(u32x4*)(o_im + 24) = zz; }
        for (int c = 0; c < 16; ++c) { const size_t ci = ((size_t)((l * 32 + g) * 16 + c)) * 64 + p;
            C.CM[((size_t)(g * 16 + c)) * 128 + p] = (bf16)f2bf(C.in(14)[ci]); C.CM[((size_t)(g * 16 + c)) * 128 + 64 + p] = (bf16)f2bf(-C.in(15)[ci]); }
    } else if (gtid < 2560) {
        const int d = gtid - 2048; const float a0 = C.in(19)[d], a1 = C.in(19)[512 + d], mx = fmaxf(a0, a1), e0 = expf(a0 - mx), e1 = expf(a1 - mx);
        const float p0 = e0 / (e0 + e1), p1 = e1 / (e0 + e1);
        C.LB[d] = (l == 0) ? (p0 - p0) : ((p0 + p1) - p0);
    }
}

__device__ __forceinline__ void rg1_load(const Ctx& C, int item, int tid, unsigned (&xw)[5]) {
    const int cidx = item >> 3, h = item & 7, t0 = cidx * 64, j = cidx & 63;
#pragma unroll
    for (int k = 0; k < 5; ++k) { const int i = tid + 512 * k, row = i >> 5, cp = i & 31; xw[k] = 0u;
        if (i < 67 * 32 && !(j == 0 && row < 3)) xw[k] = *(const unsigned*)(C.PROJ + (size_t)(t0 - 3 + row) * PW + XC_OFF + h * 64 + 2 * cp); }
}
__device__ __forceinline__ void rg1_item(const Ctx& C, unsigned char* lds, int l, int item, int tid, int wave, int lane, bool stage_w, unsigned (&xw)[5], int next_item) {
    const int cidx = item >> 3, h = item & 7, t0 = cidx * 64, j = cidx & 63, q = lane >> 4, r16 = lane & 15;
    float* XIN = (float*)lds; float* XCF = (float*)(lds + 17152); bf16* AT = (bf16*)(lds + 33536); bf16* BT = (bf16*)(lds + 42752); float* G = (float*)(lds + 61184);
    const int cc = tid & 63, chh = h * 64 + cc;
    { float bw[16];
      if (stage_w) { const int n = tid & 127; const float* wsrc = (n < 64 ? C.in(23) : C.in(25)) + ((size_t)((l * 8 + h) * 64)) * 64 + (n & 63);
#pragma unroll
        for (int k = 0; k < 16; ++k) bw[k] = wsrc[(size_t)((tid >> 7) + 4 * k) * 64];
#pragma unroll
        for (int k = 0; k < 16; ++k) BT[n * 72 + (tid >> 7) + 4 * k] = (bf16)f2bf(bw[k]); }
#pragma unroll
      for (int k = 0; k < 5; ++k) { const int i = tid + 512 * k, row = i >> 5, cp = i & 31; if (i < 67 * 32) { XIN[row * 64 + 2 * cp] = bf2f(xw[k] & 0xffffu); XIN[row * 64 + 2 * cp + 1] = bf2f(xw[k] >> 16); } } }
    const float cb_ = C.in(22)[l * 512 + chh], cw0 = C.in(21)[(l * 4 + 0) * 512 + chh], cw1 = C.in(21)[(l * 4 + 1) * 512 + chh], cw2 = C.in(21)[(l * 4 + 2) * 512 + chh], cw3 = C.in(21)[(l * 4 + 3) * 512 + chh];
    const float ba_ = C.in(24)[l * 512 + chh], bx_ = C.in(26)[l * 512 + chh];
    LBAR();
    if (next_item < 2048) rg1_load(C, next_item, tid, xw);
#pragma unroll
    for (int k = 0; k < 8; ++k) { const int t = (tid >> 6) + 8 * k, c = cc;
        const float xc = cb_ + cw0 * XIN[t * 64 + c] + cw1 * XIN[(t + 1) * 64 + c] + cw2 * XIN[(t + 2) * 64 + c] + cw3 * XIN[(t + 3) * 64 + c];
        XCF[t * 64 + c] = xc; AT[t * 72 + c] = (bf16)f2bf(xc); }
    LBAR();
    { bf16x8 bfr[2];
#pragma unroll
      for (int k = 0; k < 2; ++k) bfr[k] = *(const bf16x8*)(BT + (wave * 16 + r16) * 72 + k * 32 + q * 8);
#pragma unroll
      for (int tm = 0; tm < 4; ++tm) { f32x4 acc = {0.f, 0.f, 0.f, 0.f};
#pragma unroll
          for (int k = 0; k < 2; ++k) { const bf16x8 a = *(const bf16x8*)(AT + (tm * 16 + r16) * 72 + k * 32 + q * 8); acc = MFMA16(a, bfr[k], acc); }
#pragma unroll
          for (int jj = 0; jj < 4; ++jj) G[(tm * 16 + 4 * q + jj) * 129 + wave * 16 + r16] = acc[jj]; } }
    LBAR();
#pragma unroll
    for (int k = 0; k < 8; ++k) { const int t = (tid >> 6) + 8 * k, c = cc, ch = chh;
        const float r = sigm(G[t * 129 + c] + ba_), ig = sigm(G[t * 129 + 64 + c] + bx_);
        const unsigned rb = f2bf(r), ixb = f2bf(ig * XCF[t * 64 + c]);
        C.R[(size_t)(t0 + t) * 512 + ch] = (bf16)rb; C.IX[(size_t)(t0 + t) * 512 + ch] = (bf16)ixb;
        G[t * 129 + c] = bf2f(rb); G[t * 129 + 64 + c] = bf2f(ixb); }
    LBAR();
    { const int c = tid & 63, sg = tid >> 6, ch = h * 64 + c; const float sp8 = -8.0f * log1pf(expf(-C.in(27)[l * 512 + ch])); float A = 1.f, B = 0.f;
#pragma unroll
      for (int tt = 0; tt < 8; ++tt) { const int t = sg * 8 + tt; const float a = __expf(sp8 * G[t * 129 + c]), bb = __builtin_amdgcn_sqrtf(fmaxf(1.f - a * a, 0.f)) * G[t * 129 + 64 + c]; A *= a; B = a * B + bb; }
      XCF[(sg * 64 + c) * 2] = A; XCF[(sg * 64 + c) * 2 + 1] = B; }
    LBAR();
    if (tid < 64) { const int c = tid, ch = h * 64 + c; float A = 1.f, B = 0.f;
#pragma unroll
        for (int sg = 0; sg < 8; ++sg) { const float a = XCF[(sg * 64 + c) * 2], bb = XCF[(sg * 64 + c) * 2 + 1]; A *= a; B = a * B + bb; }
        f32x2 o; o.x = A; o.y = B; *(f32x2*)(C.AGG + ((size_t)cidx * 512 + ch) * 2) = o; }
    LBAR();
}
__device__ __forceinline__ void rgc_item(const Ctx& C, int l, int cidx, int tid) {
    const int b = cidx >> 6, j = cidx & 63, c = tid; float hst = 0.f;
    { const float* ag = C.AGG + ((size_t)(b * 64) * 512 + c) * 2;
      for (int i0 = 0; i0 < j; i0 += 16) {
          f32x2 ab[16];
#pragma unroll
          for (int k = 0; k < 16; ++k) ab[k] = *(const f32x2*)(ag + (size_t)(i0 + k) * 1024);
#pragma unroll
          for (int k = 0; k < 16; ++k) if (i0 + k < j) hst = ab[k].x * hst + ab[k].y; } }
    const float sp8 = -8.0f * log1pf(expf(-C.in(27)[l * 512 + c]));
    const bf16* rp = C.R + (size_t)cidx * 64 * 512 + c; const bf16* ip = C.IX + (size_t)cidx * 64 * 512 + c; bf16* gp = C.PROJ + (size_t)cidx * 64 * PW + GC_OFF + c;
#pragma unroll 32
    for (int t = 0; t < 64; ++t) {
        const float r = bf2f(rp[t * 512]), ix = bf2f(ip[t * 512]), gc = bf2f(gp[(size_t)t * PW]);
        const float a = __expf(sp8 * r), bb = __builtin_amdgcn_sqrtf(fmaxf(1.f - a * a, 0.f)) * ix;
        hst = a * hst + bb; gp[(size_t)t * PW] = (bf16)f2bf(hst * gc); }
}

template <bool FINAL>
__device__ __forceinline__ void s5_chunk(const Ctx& C, unsigned char* lds, int l, int item, int tid, int wave, int lane) {
    const int cidx = item >> 1, hf = item & 1, t0 = cidx * 128, q = lane >> 4, r16 = lane & 15, b = cidx >> 5, j = cidx & 31;
    bf16* UT = (bf16*)lds; float* BU = (float*)(lds + 34816) + wave * (16 * 132); bf16* XS = (bf16*)(lds + 34816 + 8 * 16 * 132 * 4) + wave * (16 * 136);
    u32x4 uw[4];
#pragma unroll
    for (int k = 0; k < 4; ++k) { const int i = tid + 512 * k, t = i >> 4, ck = i & 15; uw[k] = *(const u32x4*)(C.PROJ + (size_t)(t0 + t) * PW + UA_OFF + (2 * hf) * 128 + ck * 8); }
    for (int pp = 0; pp < 2; ++pp) {
        const int go = 2 * hf + pp, g = go * 8 + wave;
        f32x2 cs[32];
        if (FINAL) { const float* sl = C.SLOC + ((size_t)((b * 32) * 32 + g) * 64 + lane) * 2;
#pragma unroll
            for (int i = 0; i < 32; ++i) cs[i] = *(const f32x2*)(sl + (size_t)i * 4096); }
        float dsk[4];
        if (FINAL) {
#pragma unroll
            for (int jj = 0; jj < 4; ++jj) dsk[jj] = C.in(16)[l * 512 + g * 16 + 4 * q + jj]; }
        bf16x8 bfr[8];
#pragma unroll
        for (int tn = 0; tn < 8; ++tn) bfr[tn] = *(const bf16x8*)(C.BBT + ((size_t)(g * 128 + tn * 16 + r16)) * 32 + q * 8);
        const float ar = C.AR[g * 64 + lane], ai = C.AI[g * 64 + lane]; float xr = 0.f, xi = 0.f;
        bf16x8 cfr[4];
        if (FINAL) {
#pragma unroll
            for (int k = 0; k < 4; ++k) cfr[k] = *(const bf16x8*)(C.CM + ((size_t)(g * 16 + r16)) * 128 + k * 32 + q * 8); }
#pragma unroll
        for (int k = 0; k < 4; ++k) { const int i = tid + 512 * k, t = i >> 4, ck = i & 15; *(u32x4*)(UT + t * 136 + ck * 8) = uw[k]; }
        LBAR();
        if (FINAL) {
            float tr = ar, ti = ai;
#pragma unroll
            for (int s = 0; s < 7; ++s) { const float nr = tr * tr - ti * ti, ni = 2.f * tr * ti; tr = nr; ti = ni; }
#pragma unroll
            for (int i = 0; i < 32; ++i) if (i < j) { const float nr = tr * xr - ti * xi + cs[i].x, ni = tr * xi + ti * xr + cs[i].y; xr = nr; xi = ni; }
        }
        if (pp == 0) {
#pragma unroll
            for (int k = 0; k < 4; ++k) { const int i = tid + 512 * k, t = i >> 4, ck = i & 15; uw[k] = *(const u32x4*)(C.PROJ + (size_t)(t0 + t) * PW + UA_OFF + (go + 1) * 128 + ck * 8); }
        }
        for (int tm = 0; tm < 8; ++tm) {
            bf16x8 af = {0, 0, 0, 0, 0, 0, 0, 0}; if (q < 2) af = *(const bf16x8*)(UT + (tm * 16 + r16) * 136 + wave * 16 + q * 8);
#pragma unroll
            for (int tn = 0; tn < 8; ++tn) { f32x4 acc = {0.f, 0.f, 0.f, 0.f}; acc = MFMA16(af, bfr[tn], acc);
#pragma unroll
                for (int jj = 0; jj < 4; ++jj) BU[(4 * q + jj) * 132 + tn * 16 + r16] = acc[jj]; }
            LBAR();
#pragma unroll
            for (int tt = 0; tt < 16; ++tt) { const float bur = BU[tt * 132 + lane], bui = BU[tt * 132 + 64 + lane];
                const float nr = ar * xr - ai * xi + bur, ni = ar * xi + ai * xr + bui; xr = nr; xi = ni;
                if (FINAL) { XS[tt * 136 + lane] = (bf16)f2bf(xr); XS[tt * 136 + 64 + lane] = (bf16)f2bf(xi); } }
            LBAR();
            if (FINAL) {
                f32x4 acc = {0.f, 0.f, 0.f, 0.f};
#pragma unroll
                for (int k = 0; k < 4; ++k) { const bf16x8 xb = *(const bf16x8*)(XS + r16 * 136 + k * 32 + q * 8); acc = MFMA16(cfr[k], xb, acc); }
                const int t = tm * 16 + r16; const bf16* up = UT + t * 136 + wave * 16 + 4 * q; float v[4];
#pragma unroll
                for (int jj = 0; jj < 4; ++jj) v[jj] = gelu_(acc[jj] + dsk[jj] * bf2f(up[jj]));
                u32x2 o; o.x = pk2(v[0], v[1]); o.y = pk2(v[2], v[3]); *(u32x2*)(C.PROJ + (size_t)(t0 + t) * PW + UA_OFF + g * 16 + 4 * q) = o;
            }
        }
        if (!FINAL) { f32x2 o; o.x = xr; o.y = xi; *(f32x2*)(C.SLOC + ((size_t)(cidx * 32 + g) * 64 + lane) * 2) = o; }
        LBAR();
    }
}

__device__ __forceinline__ void hg_stage(const Ctx& C, unsigned char* lds, int t0, int h, int tid, float (&lfr)[16], float (&bcv)[16]) {
    float* BC = (float*)lds; bf16* VT = (bf16*)(lds + 33024); float* TOT = (float*)(lds + 33024 + 18432);
    { const int d = tid & 127, qt = tid >> 7; const bf16* p = C.PROJ + (size_t)(t0 + qt * 16) * PW + F_OFF + h * 128 + d; float loc[16]; float run = 0.f;
#pragma unroll
      for (int i = 0; i < 16; ++i) { loc[i] = bf2f(p[(size_t)i * PW]); lfr[i] = loc[i]; }
#pragma unroll
      for (int i = 0; i < 16; ++i) { run += loc[i]; loc[i] = run; }
      TOT[qt * 128 + d] = run;
      unsigned vw[8];
#pragma unroll
      for (int k = 0; k < 8; ++k) { const int i = tid + 512 * k, s = i >> 6, ep = i & 63; vw[k] = *(const unsigned*)(C.PROJ + (size_t)(t0 + s) * PW + V_OFF + h * 128 + 2 * ep); }
#pragma unroll
      for (int k = 0; k < 8; ++k) { const int i = tid + 512 * k, s = i >> 6, ep = i & 63; VT[(2 * ep) * 72 + s] = (bf16)(vw[k] & 0xffffu); VT[(2 * ep + 1) * 72 + s] = (bf16)(vw[k] >> 16); }
      LBAR();
      float off = 0.f;
      for (int qq = 0; qq < qt; ++qq) off += TOT[qq * 128 + d];
#pragma unroll
      for (int i = 0; i < 16; ++i) { bcv[i] = loc[i] + off; BC[(qt * 16 + i) * 128 + d] = bcv[i]; } }
    LBAR();
}
__device__ __forceinline__ void hg1_item(const Ctx& C, unsigned char* lds, int item, int tid, int wave, int lane) {
    const int cidx = item >> 2, h = item & 3, t0 = cidx * 64, q = lane >> 4, r16 = lane & 15;
    float* BC = (float*)lds; bf16* VT = (bf16*)(lds + 33024); bf16* KT = (bf16*)(lds + 33024 + 18432);
    float lfr[16], bcv[16];
    hg_stage(C, lds, t0, h, tid, lfr, bcv);
    { const int d = tid & 127, qt = tid >> 7; const float bl = BC[63 * 128 + d];
#pragma unroll
      for (int i = 0; i < 16; ++i) { const int s = qt * 16 + i; const float kh = (1.f - __expf(lfr[i])) * __expf(bl - bcv[i]); KT[d * 72 + s] = (bf16)f2bf(kh); }
      if (qt == 3) C.DEC[(size_t)item * 128 + d] = __expf(bl); }
    LBAR();
    bf16x8 vf[2];
#pragma unroll
    for (int k = 0; k < 2; ++k) vf[k] = *(const bf16x8*)(VT + (wave * 16 + r16) * 72 + k * 32 + q * 8);
#pragma unroll
    for (int tm = 0; tm < 8; ++tm) { f32x4 acc = {0.f, 0.f, 0.f, 0.f};
#pragma unroll
        for (int k = 0; k < 2; ++k) { const bf16x8 kf = *(const bf16x8*)(KT + (tm * 16 + r16) * 72 + k * 32 + q * 8); acc = MFMA16(kf, vf[k], acc); }
        u32x2 o; o.x = pk2(acc[0], acc[1]); o.y = pk2(acc[2], acc[3]);
        *(u32x2*)(C.HGS + ((size_t)item * 128 + wave * 16 + r16) * 128 + tm * 16 + 4 * q) = o; }
    LBAR();
}
__device__ __forceinline__ void hg2_elem(const Ctx& C, int idx) {
    const int dp = idx & 63, e = (idx >> 6) & 127, h = (idx >> 13) & 3, b = idx >> 15; float s0 = 0.f, s1 = 0.f;
#pragma unroll 32
    for (int j = 0; j < 64; ++j) { const size_t item = (size_t)(b * 64 + j) * 4 + h; unsigned* p = (unsigned*)(C.HGS + (item * 128 + e) * 128 + 2 * dp);
        const f32x2 dc = *(const f32x2*)(C.DEC + item * 128 + 2 * dp); const unsigned w = *p; *p = pk2(s0, s1);
        s0 = dc.x * s0 + bf2f(w & 0xffffu); s1 = dc.y * s1 + bf2f(w >> 16); }
}
__device__ __forceinline__ void hg3_item(const Ctx& C, unsigned char* lds, int l, int item, int tid, int wave, int lane) {
    const int cidx = item >> 2, h = item & 3, t0 = cidx * 64, q = lane >> 4, r16 = lane & 15;
    float* BC = (float*)lds; float* OF = (float*)lds; bf16* VT = (bf16*)(lds + 33024); bf16* QB = (bf16*)(lds + 51456); bf16* QT = (bf16*)(lds + 68864);
    bf16* K0 = (bf16*)(lds + 86272); bf16* K1 = (bf16*)(lds + 94976); bf16* P = (bf16*)(lds + 112384);
    bf16x8 sf[4];
#pragma unroll
    for (int k = 0; k < 4; ++k) sf[k] = *(const bf16x8*)(C.HGS + ((size_t)item * 128 + wave * 16 + r16) * 128 + k * 32 + q * 8);
    float qv_[16], lfr[16], bcv[16];
    { const int d = tid & 127, qt = tid >> 7; const bf16* pr = C.PROJ + (size_t)(t0 + qt * 16) * PW + Q_OFF + h * 128 + d;
#pragma unroll
      for (int i = 0; i < 16; ++i) qv_[i] = bf2f(pr[(size_t)i * PW]); }
    hg_stage(C, lds, t0, h, tid, lfr, bcv);
    { const int d = tid & 127, qt = tid >> 7; const float r1 = BC[31 * 128 + d];
#pragma unroll
      for (int i = 0; i < 16; ++i) { const int t = qt * 16 + i;
        const float qv = qv_[i], bt = bcv[i], kv = (1.f - __expf(lfr[i]));
        QB[t * 136 + d] = (bf16)f2bf(qv * __expf(bt)); QT[t * 136 + d] = (bf16)f2bf(qv * __expf(bt - (qt >= 2 ? r1 : 0.f)));
        if (qt < 2) K0[t * 136 + d] = (bf16)f2bf(kv * __expf(fminf(-bt, 80.f)));
        K1[t * 136 + d] = (bf16)f2bf(kv * __expf(fminf(r1 - bt, 80.f))); } }
    for (int i = tid; i < 1024; i += 512) P[(i >> 5) * 72 + 32 + (i & 31)] = 0;
    LBAR();
    for (int tile = wave; tile < 12; tile += 8) { int tm, tn; const bf16* KB;
        if (tile < 4) { tm = tile >> 1; tn = tile & 1; KB = K0; } else { const int tt = tile - 4; tm = 2 + (tt >> 2); tn = tt & 3; KB = K1; }
        f32x4 acc = {0.f, 0.f, 0.f, 0.f};
#pragma unroll
        for (int k = 0; k < 4; ++k) { const bf16x8 a = *(const bf16x8*)(QT + (tm * 16 + r16) * 136 + k * 32 + q * 8); const bf16x8 bb = *(const bf16x8*)(KB + (tn * 16 + r16) * 136 + k * 32 + q * 8); acc = MFMA16(a, bb, acc); }
        const int s = tn * 16 + r16;
#pragma unroll
        for (int jj = 0; jj < 4; ++jj) { const int t = tm * 16 + 4 * q + jj; P[t * 72 + s] = (s <= t) ? (bf16)f2bf(acc[jj]) : (bf16)0; } }
    LBAR();
    { bf16x8 vf[2];
#pragma unroll
      for (int k = 0; k < 2; ++k) vf[k] = *(const bf16x8*)(VT + (wave * 16 + r16) * 72 + k * 32 + q * 8);
#pragma unroll
      for (int tm = 0; tm < 4; ++tm) { f32x4 acc = {0.f, 0.f, 0.f, 0.f};
#pragma unroll
          for (int k = 0; k < 4; ++k) { const bf16x8 a = *(const bf16x8*)(QB + (tm * 16 + r16) * 136 + k * 32 + q * 8); acc = MFMA16(a, sf[k], acc); }
#pragma unroll
          for (int k = 0; k < 2; ++k) { const bf16x8 a = *(const bf16x8*)(P + (tm * 16 + r16) * 72 + k * 32 + q * 8); acc = MFMA16(a, vf[k], acc); }
#pragma unroll
          for (int jj = 0; jj < 4; ++jj) OF[(tm * 16 + 4 * q + jj) * 129 + wave * 16 + r16] = acc[jj]; } }
    LBAR();
    { const int t = tid >> 3, e0 = (tid & 7) * 16; float o[16], ss = 0.f;
#pragma unroll
      for (int i = 0; i < 16; ++i) { o[i] = OF[t * 129 + e0 + i]; ss += o[i] * o[i]; }
      ss += __shfl_xor(ss, 1); ss += __shfl_xor(ss, 2); ss += __shfl_xor(ss, 4);
      const float rstd = __builtin_amdgcn_rsqf(ss * (1.f / 128.f) + 1e-6f);
      bf16* row = C.PROJ + (size_t)(t0 + t) * PW + h * 128 + e0; const float* nw = C.in(20) + l * 512 + h * 128 + e0;
#pragma unroll
      for (int hf = 0; hf < 2; ++hf) { float gg[8], v[8]; load8(row + G_OFF + hf * 8, gg);
#pragma unroll
          for (int i = 0; i < 8; ++i) v[i] = o[hf * 8 + i] * rstd * nw[hf * 8 + i] * gg[i];
          store8(row + Q_OFF + hf * 8, v); } }
    LBAR();
}

#define LAS __attribute__((address_space(3)))
#define XB_TMO      128
#define XB_XCNT(j)  (256  + 64 * (j))
#define XB_XSUB(j)  (1280 + 64 * (j))
#define XB_XGEN(j)  (2304 + 64 * (j))
#define XB_TOP      3328
#define XB_TOPGEN   3392
#define XCD_BAR_WORDS 3456
#define XB_SPIN_CAP (1u << 18)

__device__ __forceinline__ unsigned xb_ld(unsigned* p)              { return __hip_atomic_load(p, __ATOMIC_RELAXED, __HIP_MEMORY_SCOPE_AGENT); }
__device__ __forceinline__ unsigned xb_add(unsigned* p, unsigned v) { return __hip_atomic_fetch_add(p, v, __ATOMIC_RELAXED, __HIP_MEMORY_SCOPE_AGENT); }
__device__ __forceinline__ unsigned xb_xcc_id() { return (unsigned)__builtin_amdgcn_s_getreg((3 << 11) | 20) & 0xFu; }
#define XB_SPIN(cond, bar) do { unsigned _sp = 0; while (cond) { __builtin_amdgcn_s_sleep(1); \
    if ((++_sp & 255u) == 0u) { if (xb_ld(&(bar)[XB_TMO])) break; if (_sp > XB_SPIN_CAP) { atomicAdd(&(bar)[XB_TMO], 1u); break; } } } } while (0)

struct XcdBarrier {
    unsigned* bar; unsigned x;
    volatile LAS unsigned* st;
};

__device__ __forceinline__ XcdBarrier xcd_barrier_post(unsigned* bar, volatile LAS unsigned* st) {
    XcdBarrier b; b.bar = bar; b.x = xb_xcc_id(); b.st = st;
    if (threadIdx.x == 0) (void)xb_add(&bar[XB_XCNT(b.x)], 1u);
    return b;
}
__device__ __forceinline__ void xcd_barrier_complete(unsigned* bar, unsigned x, unsigned& nloc, unsigned& nx) {
    const unsigned G = gridDim.x * gridDim.y * gridDim.z;
    unsigned sum, cnt, mine, sp = 0u;
    for (;;) {
        sum = 0u; cnt = 0u; mine = 0u;
#pragma unroll
        for (unsigned j = 0; j < 16; ++j) { const unsigned c = xb_ld(&bar[XB_XCNT(j)]); sum += c; cnt += (c > 0u) ? 1u : 0u; mine = (j == x) ? c : mine; }
        if (sum == G) break;
        __builtin_amdgcn_s_sleep(1);
        if ((++sp & 255u) == 0u) { if (xb_ld(&bar[XB_TMO])) break; if (sp > XB_SPIN_CAP) { atomicAdd(&bar[XB_TMO], 1u); break; } }
    }
    nloc = mine > 0u ? mine : 1u; nx = cnt > 0u ? cnt : 1u;
}

__device__ __forceinline__ void xcd_barrier(const XcdBarrier& b) {
    asm volatile("s_waitcnt vmcnt(0)" ::: "memory");
    __syncthreads();
    if (threadIdx.x == 0) {
        unsigned* bar = b.bar;
        __builtin_amdgcn_s_waitcnt(0);
        unsigned nloc = b.st[0], nx = b.st[1];
        if (nloc == 0u) { xcd_barrier_complete(bar, b.x, nloc, nx); b.st[0] = nloc; b.st[1] = nx; }
        const unsigned old = xb_add(&bar[XB_XSUB(b.x)], 1u);
        const unsigned gen = old / nloc;
        if (old + 1u == (gen + 1u) * nloc) {
            __builtin_amdgcn_fence(__ATOMIC_RELEASE, "agent");
            asm volatile("s_waitcnt vmcnt(0)" ::: "memory");
            const unsigned og = xb_add(&bar[XB_TOP], 1u);
            const unsigned tg = og / nx;
            if (og + 1u == (tg + 1u) * nx) xb_add(&bar[XB_TOPGEN], 1u);
            else XB_SPIN(xb_ld(&bar[XB_TOPGEN]) == tg, bar);
            __builtin_amdgcn_fence(__ATOMIC_ACQUIRE, "agent");
            xb_add(&bar[XB_XGEN(b.x)], 1u);
            asm volatile("s_waitcnt vmcnt(0)" ::: "memory");
        } else {
            XB_SPIN(xb_ld(&bar[XB_XGEN(b.x)]) == gen, bar);
            __builtin_amdgcn_fence(__ATOMIC_ACQUIRE, "agent");
            asm volatile("s_waitcnt vmcnt(0)" ::: "memory");
        }
    }
    __syncthreads();
}

__device__ __forceinline__ void team_sync(unsigned* word, int tid, int same_xcd) {
    asm volatile("s_waitcnt vmcnt(0)" ::: "memory");
    __syncthreads();
    if (tid == 0) {
        if (!same_xcd) { __builtin_amdgcn_fence(__ATOMIC_RELEASE, "agent"); asm volatile("s_waitcnt vmcnt(0)" ::: "memory"); }
        (void)xb_add(word, 1u);
        unsigned sp = 0u;
        while (xb_ld(word) < 4u) { __builtin_amdgcn_s_sleep(1); if (++sp > (1u << 22)) break; }
        __builtin_amdgcn_fence(__ATOMIC_ACQUIRE, "agent");
        asm volatile("s_waitcnt vmcnt(0)" ::: "memory");
    }
    __syncthreads();
}

struct Args { const float* in[28]; float* out; unsigned char* ws; int ph_lo, ph_hi; };
__global__ void __launch_bounds__(512, 2) fwd_megakernel(Args args) {
    extern __shared__ __attribute__((aligned(16))) unsigned char lds[];
    cg::grid_group grid = cg::this_grid();
    PG8_LAS unsigned char* ldsl = (PG8_LAS unsigned char*)lds;
    if (threadIdx.x < 16) ((volatile LAS unsigned*)(ldsl + LDS_PHASE))[threadIdx.x] = 0u;
    __syncthreads();
    int team_same = 0;
    XcdBarrier xbar = xcd_barrier_post((unsigned*)(args.ws + WS_BAR), (volatile LAS unsigned*)(ldsl + LDS_PHASE));
    if (threadIdx.x == 0) __hip_atomic_store((unsigned*)(args.ws + WS_TEAMX) + blockIdx.x, xbar.x + 1u, __ATOMIC_RELAXED, __HIP_MEMORY_SCOPE_AGENT);
    if (args.ph_hi > 1000) grid.sync();
    for (int ph = args.ph_lo; ph < args.ph_hi; ++ph) {
        if (ph == args.ph_lo + 1) xcd_barrier(xbar);
        else if (ph > args.ph_lo + 1) {
            const int sp_ = (ph - 1) % 14, lp_ = (ph - 1) / 14;
            if (ph == args.ph_lo + 3 && gridDim.x == 256) {
                const unsigned* tx = (const unsigned*)(args.ws + WS_TEAMX); const int c0 = blockIdx.x & 63; unsigned same = 1u;
                const unsigned me = xb_ld((unsigned*)tx + blockIdx.x);
#pragma unroll
                for (int k = 0; k < 4; ++k) same &= (xb_ld((unsigned*)tx + c0 + 64 * k) == me) ? 1u : 0u;
                team_same = __builtin_amdgcn_readfirstlane((int)(same & (me != 0u ? 1u : 0u)));
            }
            if (gridDim.x == 256 && (sp_ == 2 || sp_ == 3 || sp_ == 8 || sp_ == 9 || sp_ == 13)) {
                const int c_ = blockIdx.x, pm_ = 8 * (c_ & 7) + ((c_ >> 3) & 7);
                team_sync((unsigned*)(args.ws + WS_TEAM) + (size_t)(ph * 64 + pm_) * 64, threadIdx.x, team_same);
            } else xcd_barrier(xbar);
        }
        int tid = threadIdx.x; asm volatile("" : "+v"(tid));
        int bid = blockIdx.x, G = gridDim.x; asm volatile("" : "+s"(bid), "+s"(G));
        __attribute__((address_space(1))) unsigned char* wsg = (__attribute__((address_space(1))) unsigned char*)args.ws; asm volatile("" : "+s"(wsg)); unsigned char* ws = (unsigned char*)wsg;
        Ctx C;
        { KArgP kb = (KArgP)__builtin_amdgcn_kernarg_segment_ptr(); asm volatile("" : "+s"(kb)); C.kin = kb; }
        C.X = args.out; C.ws = ws;
        C.LB = (float*)(ws + WS_LB); C.AR = (float*)(ws + WS_AR); C.AI = (float*)(ws + WS_AI); C.DEC = (float*)(ws + WS_DEC); C.AGG = (float*)(ws + WS_AGG); C.SLOC = (float*)(ws + WS_SLOC);
        C.BBT = (bf16*)(ws + WS_BBT); C.CM = (bf16*)(ws + WS_CM); C.W = (bf16*)(ws + WS_W); C.HB = (bf16*)(ws + WS_HB); C.PROJ = (bf16*)(ws + WS_PROJ);
        C.R = (bf16*)(ws + WS_R); C.IX = (bf16*)(ws + WS_IX); C.HGS = (bf16*)(ws + WS_HGS); C.GM = (bf16*)(ws + WS_GM);
        const int lane = tid & 63, wave = __builtin_amdgcn_readfirstlane(tid >> 6);
        const int gw = bid * 8 + wave, NGW = G * 8, gtid = bid * 512 + tid;
        float* scr = (float*)(lds + wave * 16384);
        const bool team_ = (G == 256);
        const int prow_ = (8 * (bid & 7) + ((bid >> 3) & 7)) * 256 + (bid >> 6) * 64 + wave * 8;
        if (ph == NPH - 1) { if (team_) final_norm_rows(C.X, C.in(2), prow_, 1, prow_ + 8, lane); else final_norm_rows(C.X, C.in(2), gw, NGW, NTOK, lane); continue; }
        const int l = ph / 14, s = ph % 14;
        int ngemm = 0;
        if (s == 0 || s == 11) {
            const int j = (s == 0) ? 0 : 1;
            if (team_ && s == 0 && l > 0) norm_rows(C.X, nullptr, C.in(1) + (l * 3) * DM, C.HB, prow_, 1, prow_ + 8, lane);
            else norm_rows((l == 0 && s == 0) ? C.in(0) : C.X, nullptr, C.in(1) + (l * 3 + (j ? 2 : 0)) * DM, C.HB, gw, NGW, NTOK, lane);
            convert_ffn(C, l, j, scr, gw, NGW, lane, 0);
        } else if (s == 3) {
            if (team_) norm_rows(C.X, nullptr, C.in(1) + (l * 3 + 1) * DM, C.HB, prow_, 1, prow_ + 8, lane);
            else norm_rows(C.X, nullptr, C.in(1) + (l * 3 + 1) * DM, C.HB, gw, NGW, NTOK, lane);
            if (!team_) { convert_mixer(C, l, scr, gw, NGW, lane, 0); make_tables(C, l, gtid); }
        } else if (s == 5) {
            { unsigned xw[5]; if (bid < 2048) rg1_load(C, bid, tid, xw);
              for (int it = bid; it < 2048; it += G) rg1_item(C, lds, l, it, tid, wave, lane, it == bid || (G & 7) != 0, xw, it + G); }
            for (int it = bid; it < 256; it += G) s5_chunk<false>(C, lds, l, it, tid, wave, lane);
            for (int it = bid; it < 1024; it += G) hg1_item(C, lds, it, tid, wave, lane);
        } else if (s == 6) {
            for (int it = bid; it < 256; it += G) rgc_item(C, l, it, tid);
            for (int idx = gtid; idx < 131072; idx += G * 512) hg2_elem(C, idx);
            for (int it = bid; it < 256; it += G) s5_chunk<true>(C, lds, l, it, tid, wave, lane);
        } else if (s == 7) {
            if (G == 256) { const int nit = (bid < 128) ? 3 : 5, base = (bid < 128) ? bid * 3 : 384 + (bid - 128) * 5;
                for (int k = 0; k < nit; ++k) hg3_item(C, lds, l, base + k, tid, wave, lane); }
            else for (int it = bid; it < 1024; it += G) hg3_item(C, lds, l, it, tid, wave, lane);
            ngemm = 1;
        }
        else ngemm = 1;
        for (int gi = 0; gi < ngemm; ++gi) {
            pg8::Gemm g; int nseg = 1; Epi E; E.mode = 0; E.O = nullptr; E.ldc = 0; E.X = C.X; E.Xsrc = (l == 0 && s == 2) ? C.in(0) : C.X; E.scale = 1.f; E.aux = nullptr; E.ldaux = 0; E.vec = nullptr; E.first = 0;
            if (s == 1 || s == 12) { g = pg8::Gemm{C.HB, C.W + W_GU, NTOK, 2 * DFF, DM, DM, 0, 0, 0, 0}; E.mode = 0; E.O = (bf16*)(ws + WS_ACT); E.ldc = DFF; }
            else if (s == 2 || s == 13) { g = pg8::Gemm{(bf16*)(ws + WS_ACT), C.W + W_D, NTOK, DM, DFF, DFF, 0, 0, 0, 0}; E.mode = 1; E.scale = 0.5f; }
            else if (s == 4) { g = pg8::Gemm{C.HB, (bf16*)(ws + WS_WI0), NTOK, PW, DM, DM, 0, 0, 0, 0}; E.mode = 2; E.O = C.PROJ; E.ldc = PW; E.vec = C.LB; }
            else if (s == 7) { g = pg8::Gemm{C.PROJ + UA_OFF, C.W + W_GLU, NTOK, 512, 512, PW, 0, 0, 0, 0}; E.mode = 3; E.O = C.PROJ + XC_OFF; E.ldc = PW; E.aux = C.PROJ + UA_OFF; E.ldaux = PW; E.vec = C.in(18) + l * 512; }
            else if (s == 8) { g = pg8::Gemm{C.HB, C.W + W_GMW, NTOK, GMW, DM, DM, 0, 0, 0, 0}; E.mode = 4; E.O = C.GM; E.ldc = GMW; }
            else if (s == 9) { g = pg8::Gemm{C.PROJ, C.W + W_BP, NTOK, DM, 512, PW, XC_OFF * 2, Q_OFF * 2, GC_OFF * 2, DM * 512 * 2};
                E.mode = 5; E.O = C.HB; E.ldc = DM; E.aux = C.GM; E.ldaux = GMW; nseg = 3; }
            else { g = pg8::Gemm{C.HB, C.W + W_WO, NTOK, DM, DM, DM, 0, 0, 0, 0}; E.mode = 1; E.scale = 1.f; }
            pg8::StaticOrder S; S.init(g.M, g.N, G, bid, nseg);
            pg8::gemm_phase<Epi, pg8::StaticOrder, true, true>(ldsl, g, S, E, tid);
            __syncthreads();
        }
        if (s == 1 || s == 12 || s == 4) {
            int tid2 = threadIdx.x, bid2 = blockIdx.x, G2 = gridDim.x; asm volatile("" : "+v"(tid2)); asm volatile("" : "+s"(bid2), "+s"(G2));
            if (bid2 >= (G2 >> 1)) { const int wv2 = __builtin_amdgcn_readfirstlane(tid2 >> 6), hw = (bid2 - (G2 >> 1)) * 8 + wv2, HNW = (G2 - (G2 >> 1)) * 8; float* scr2 = (float*)(lds + wv2 * 16384);
                if (s == 4) convert_mixer(C, l, scr2, hw, HNW, tid2 & 63, 1); else convert_ffn(C, l, s == 1 ? 0 : 1, scr2, hw, HNW, tid2 & 63, 1);
                if (s == 1 && G2 == 256) { convert_mixer(C, l, scr2, hw, HNW, tid2 & 63, 0); make_tables(C, l, (bid2 - (G2 >> 1)) * 512 + tid2); } }
        }
    }
}

extern "C" void kernel_launch(void* const* d_in, const int* in_sizes, int n_in, void* d_out, int out_size, void* d_ws, size_t ws_size, hipStream_t stream) {
    static int grid = 0;
    if (grid == 0) {
        if (n_in != 28 || out_size != NTOK * DM || ws_size < WS_END) { fprintf(stderr, "kernel_launch: unexpected shapes (n_in %d out %d ws %zu)\n", n_in, out_size, ws_size); grid = -1; return; }
        int dev = 0, cus = 0, per_cu = 0;
        hipGetDevice(&dev); hipDeviceGetAttribute(&cus, hipDeviceAttributeMultiprocessorCount, dev);
        hipFuncSetAttribute((const void*)fwd_megakernel, hipFuncAttributeMaxDynamicSharedMemorySize, LDS_BYTES);
        hipOccupancyMaxActiveBlocksPerMultiprocessor(&per_cu, (const void*)fwd_megakernel, 512, LDS_BYTES);
        if (per_cu < 1 || cus < 1) { fprintf(stderr, "kernel_launch: occupancy query says %d blocks per CU (%d CUs)\n", per_cu, cus); grid = -1; return; }
        grid = cus;
    }
    if (grid < 0) return;
    if (hipMemsetAsync((char*)d_ws + WS_TEAM, 0, CTL_BYTES, stream) != hipSuccess) { fprintf(stderr, "kernel_launch: hipMemsetAsync of the control words failed\n"); return; }
    Args a{};
    for (int i = 0; i < 28; ++i) a.in[i] = (const float*)d_in[i];
    a.out = (float*)d_out; a.ws = (unsigned char*)d_ws; a.ph_lo = 0; a.ph_hi = NPH;
    void* kargs[] = {&a};
    hipError_t e = hipLaunchCooperativeKernel((const void*)fwd_megakernel, dim3(grid), dim3(512), kargs, LDS_BYTES, stream);
    if (e != hipSuccess) fprintf(stderr, "cooperative launch failed: %s (grid %d)\n", hipGetErrorString(e), grid);
}
```

```cpp
#include <hip/hip_runtime.h>
#include <hip/hip_cooperative_groups.h>
#include <cstdio>
#include <cstdint>
namespace cg = cooperative_groups;
namespace pg8 {
#define PG8_LAS __attribute__((address_space(3)))
typedef unsigned short bf16_t;
typedef short bf16x8 __attribute__((ext_vector_type(8)));
typedef float f32x4 __attribute__((ext_vector_type(4)));
typedef unsigned u32x4 __attribute__((ext_vector_type(4)));
constexpr int BM = 256, BK = 64, HALF = 128, HTB = HALF * BK * 2  , STAGE_BYTES = 8 * HTB, NXCD = 8, WGM = 8;

__host__ __device__ __forceinline__ int lds_byte(int r, int c) { const int st = (r >> 4) * 2 + (c >> 5), rr = r & 15, cc = c & 31, ob = rr * 64 + cc * 2; return st * 1024 + (ob ^ (((ob >> 9) & 1) << 5)); }
__host__ __device__ __forceinline__ void stage_rc(int b, int& R, int& C) { const int st = b / 1024, sb = b % 1024, swz = sb ^ (((sb >> 9) & 1) << 5); R = (st >> 1) * 16 + swz / 64; C = (st & 1) * 32 + (swz % 64) / 2; }
__host__ __device__ __forceinline__ int perm32(int rho) { const int n = rho >> 4, i = rho & 15; return 8 * (i >> 2) + 4 * n + (i & 3); }

struct Unit { int pm, pn, sg; };
struct Gemm { const bf16_t* A; const bf16_t* Bt; int M, N, K, lda; int so0, so1, so2, bseg; };

struct StaticOrder {
    int nM, nN, nwg, G, c, nseg;
    __host__ __device__ void init(int M, int N, int G_, int c_, int nseg_ = 1) { nM = M / BM; nN = N / BM; nwg = nM * nN; G = G_; c = c_; nseg = nseg_; }
    __host__ __device__ bool next(int i, Unit& u) const {
        const int ib = i / nseg; u.sg = i - ib * nseg;
        const long L = (long)ib * G + c; if (L >= nwg) return false;
        int wgid = (int)L; { const int q = nwg / NXCD, r = nwg % NXCD, xcd = wgid % NXCD, off = wgid / NXCD; wgid = (xcd < r ? xcd * (q + 1) : r * (q + 1) + (xcd - r) * q) + off; }
        const int nig = WGM * nN, gid = wgid / nig, fm = gid * WGM, gsz = (nM - fm) < WGM ? (nM - fm) : WGM;
        u.pm = fm + ((wgid % nig) % gsz); u.pn = (wgid % nig) / gsz; return true;
    }
    __device__ __forceinline__ void a_ready(const Unit&) const {}
    __device__ __forceinline__ void done(const Unit&) const {}
};


template <class Epi, class Sched, bool ALIGN_EPI = false, bool SP2 = false>
__device__ __forceinline__ void gemm_phase(PG8_LAS unsigned char* lds, const Gemm g, const Sched& S, const Epi& E, const int tid) {
    const int wid = __builtin_amdgcn_readfirstlane(tid >> 6), lane = tid & 63, wr = wid >> 2, wc = wid & 3, fr = lane & 15, fq = lane >> 4;
    const int K = g.K, nt = K / BK;
    unsigned voffA[2], voffB[2];
#pragma unroll
    for (int i = 0; i < 2; ++i) { int R, C; stage_rc(tid * 16 + i * 8192, R, C); const int Rb = Epi::PERM ? ((R & ~31) + perm32(R & 31)) : R;
        voffA[i] = (unsigned)(R * g.lda + C) * 2u; voffB[i] = (unsigned)(Rb * K + C) * 2u; }
    const size_t kstep = (size_t)(BK * 2);
    const size_t hstepA = (size_t)HALF * g.lda * 2, hstepB = (size_t)HALF * K * 2;
    const size_t tstepA = 2 * hstepA, tstepB = 2 * hstepB;
    const unsigned ldsw = (unsigned)wid * 1024u;
    const int aoff = lds_byte(wr * 64 + fr, fq * 8), boff = lds_byte(wc * 32 + fr, fq * 8);
#define PG8_SA(b, h) (((b) * 2 + (h)) * HTB)
#define PG8_SB(b, h) ((4 + (b) * 2 + (h)) * HTB)
#define PG8_STAGE(bufoff, gbase, voff) do { _Pragma("unroll") for (int _i = 0; _i < 2; ++_i) \
        __builtin_amdgcn_global_load_lds((const unsigned*)((const char*)(gbase) + (voff)[_i]), (PG8_LAS unsigned*)(lds + (bufoff) + ldsw + _i * 8192), 16, 0, 0); } while (0)
#define PG8_LDA(dst, b, h) do { _Pragma("unroll") for (int m = 0; m < 4; ++m) _Pragma("unroll") for (int k = 0; k < 2; ++k) dst[m][k] = *(const PG8_LAS bf16x8*)(lds + PG8_SA(b, h) + aoff + m * 2048 + k * 1024); } while (0)
#define PG8_LDB(dst, b, h) do { _Pragma("unroll") for (int n = 0; n < 2; ++n) _Pragma("unroll") for (int k = 0; k < 2; ++k) dst[n][k] = *(const PG8_LAS bf16x8*)(lds + PG8_SB(b, h) + boff + n * 2048 + k * 1024); } while (0)
#define PG8_MMA(ai, bj, At, Bt) do { __builtin_amdgcn_s_setprio(1); _Pragma("unroll") for (int m = 0; m < 4; ++m) _Pragma("unroll") for (int n = 0; n < 2; ++n) _Pragma("unroll") for (int k = 0; k < 2; ++k) \
        acc[ai][bj][m][n] = __builtin_amdgcn_mfma_f32_16x16x32_bf16(Bt[n][k], At[m][k], acc[ai][bj][m][n], 0, 0, 0); __builtin_amdgcn_s_setprio(0); } while (0)
#define PG8_WAIT_V(n) asm volatile("s_waitcnt vmcnt(" #n ")" ::: "memory")
#define PG8_WAIT_L(n) asm volatile("s_waitcnt lgkmcnt(" #n ")" ::: "memory")
#define PG8_BAR __builtin_amdgcn_s_barrier()
#define PG8_SCHED __builtin_amdgcn_sched_barrier(0)
    Unit cur, nxt; int ui = 0;
    if (!S.next(0, cur)) return;
    f32x4 acc[2][2][4][2];
#pragma unroll
    for (int a = 0; a < 2; ++a)
#pragma unroll
        for (int b = 0; b < 2; ++b)
#pragma unroll
            for (int m = 0; m < 4; ++m)
#pragma unroll
                for (int n = 0; n < 2; ++n) acc[a][b][m][n] = (f32x4){0.f, 0.f, 0.f, 0.f};
    bf16x8 At[4][2], B0[2][2], B1[2][2];
#define PG8_SO(u) ((size_t)((u).sg == 0 ? g.so0 : ((u).sg == 1 ? g.so1 : g.so2)))
    const char* cA = (const char*)g.A + (size_t)cur.pm * tstepA + PG8_SO(cur); const char* cB = (const char*)g.Bt + (size_t)cur.pn * tstepB + (size_t)cur.sg * g.bseg;
    S.a_ready(cur);
    if constexpr (SP2) {
        PG8_STAGE(PG8_SB(0, 0), cB, voffB); PG8_STAGE(PG8_SB(0, 1), cB + hstepB, voffB); PG8_STAGE(PG8_SA(0, 0), cA, voffA); PG8_STAGE(PG8_SA(0, 1), cA + hstepA, voffA);
        if (wr == 1) PG8_BAR;
        PG8_WAIT_V(2); PG8_BAR;
        PG8_STAGE(PG8_SB(1, 0), cB + kstep, voffB); PG8_STAGE(PG8_SA(1, 0), cA + kstep, voffA); PG8_STAGE(PG8_SB(1, 1), cB + hstepB + kstep, voffB);
        PG8_WAIT_V(6); PG8_BAR;
    } else {
        PG8_STAGE(PG8_SB(0, 0), cB, voffB); PG8_STAGE(PG8_SA(0, 0), cA, voffA); PG8_STAGE(PG8_SB(0, 1), cB + hstepB, voffB); PG8_STAGE(PG8_SA(0, 1), cA + hstepA, voffA);
        if (wr == 1) PG8_BAR;
        PG8_WAIT_V(4); PG8_BAR;
        PG8_STAGE(PG8_SB(1, 0), cB + kstep, voffB); PG8_STAGE(PG8_SA(1, 0), cA + kstep, voffA); PG8_STAGE(PG8_SB(1, 1), cB + hstepB + kstep, voffB);
        PG8_WAIT_V(6); PG8_BAR;
    }
    for (;;) {
        const bool has_next = S.next(ui + 1, nxt);
        const char* nA = has_next ? (const char*)g.A + (size_t)nxt.pm * tstepA + PG8_SO(nxt) : cA; const char* nB = has_next ? (const char*)g.Bt + (size_t)nxt.pn * tstepB + (size_t)nxt.sg * g.bseg : cB;
        for (int t = 0; t < nt; t += 2) {
            const bool last = (t == nt - 2);
            const char* a1 = cA + (size_t)(t + 1) * kstep;
            const char* a2 = last ? nA : cA + (size_t)(t + 2) * kstep; const char* b2 = last ? nB : cB + (size_t)(t + 2) * kstep;
            const char* a3 = a2 + kstep; const char* b3 = b2 + kstep;
            if (last && has_next) S.a_ready(nxt);
            if constexpr (SP2) {
            PG8_LDB(B0, 0, 0); PG8_LDB(B1, 0, 1); PG8_SCHED; PG8_LDA(At, 0, 0); PG8_STAGE(PG8_SA(1, 1), a1 + hstepA, voffA);
            PG8_WAIT_V(8); PG8_WAIT_L(0); PG8_BAR; PG8_MMA(0, 0, At, B0); PG8_MMA(0, 1, At, B1); PG8_BAR; PG8_SCHED;
            PG8_LDA(At, 0, 1); PG8_STAGE(PG8_SB(0, 0), b2, voffB); PG8_STAGE(PG8_SB(0, 1), b2 + hstepB, voffB); PG8_STAGE(PG8_SA(0, 0), a2, voffA);
            PG8_WAIT_V(8); PG8_WAIT_L(0); PG8_BAR; PG8_MMA(1, 0, At, B0); PG8_MMA(1, 1, At, B1); PG8_BAR; PG8_SCHED;
            PG8_LDB(B0, 1, 0); PG8_LDB(B1, 1, 1); PG8_SCHED; PG8_LDA(At, 1, 0); PG8_STAGE(PG8_SA(0, 1), a2 + hstepA, voffA);
            PG8_WAIT_V(8); PG8_WAIT_L(0); PG8_BAR; PG8_MMA(0, 0, At, B0); PG8_MMA(0, 1, At, B1); PG8_BAR; PG8_SCHED;
            PG8_LDA(At, 1, 1); PG8_STAGE(PG8_SB(1, 0), b3, voffB); PG8_STAGE(PG8_SB(1, 1), b3 + hstepB, voffB); PG8_STAGE(PG8_SA(1, 0), a3, voffA);
            PG8_WAIT_V(8); PG8_WAIT_L(0); PG8_BAR; PG8_MMA(1, 0, At, B0); PG8_MMA(1, 1, At, B1); PG8_BAR; PG8_SCHED;
            } else {
            PG8_LDB(B0, 0, 0); PG8_SCHED; PG8_LDA(At, 0, 0); PG8_STAGE(PG8_SA(1, 1), a1 + hstepA, voffA);
            PG8_WAIT_L(8); PG8_BAR; PG8_WAIT_L(0); PG8_MMA(0, 0, At, B0); PG8_BAR; PG8_SCHED;
            PG8_LDB(B1, 0, 1); PG8_STAGE(PG8_SB(0, 0), b2, voffB);
            PG8_BAR; PG8_WAIT_L(0); PG8_MMA(0, 1, At, B1); PG8_BAR;
            PG8_LDA(At, 0, 1); PG8_STAGE(PG8_SA(0, 0), a2, voffA);
            PG8_BAR; PG8_WAIT_L(0); PG8_MMA(1, 0, At, B0); PG8_BAR; PG8_SCHED;
            PG8_STAGE(PG8_SB(0, 1), b2 + hstepB, voffB);
            PG8_WAIT_V(6); PG8_BAR; PG8_MMA(1, 1, At, B1); PG8_BAR;
            PG8_LDB(B0, 1, 0); PG8_SCHED; PG8_LDA(At, 1, 0); PG8_STAGE(PG8_SA(0, 1), a2 + hstepA, voffA);
            PG8_WAIT_L(8); PG8_BAR; PG8_WAIT_L(0); PG8_MMA(0, 0, At, B0); PG8_BAR; PG8_SCHED;
            PG8_LDB(B1, 1, 1); PG8_STAGE(PG8_SB(1, 0), b3, voffB);
            PG8_BAR; PG8_WAIT_L(0); PG8_MMA(0, 1, At, B1); PG8_BAR;
            PG8_LDA(At, 1, 1); PG8_STAGE(PG8_SA(1, 0), a3, voffA);
            PG8_BAR; PG8_WAIT_L(0); PG8_MMA(1, 0, At, B0); PG8_BAR; PG8_SCHED;
            PG8_STAGE(PG8_SB(1, 1), b3 + hstepB, voffB);
            PG8_WAIT_V(6); PG8_BAR; PG8_MMA(1, 1, At, B1); PG8_BAR;
            }
        }
        if constexpr (ALIGN_EPI) { if (wr == 0) PG8_BAR; }
        if (!E.drain()) { E(acc, cur, wr, wc, fr, fq); S.done(cur); }
        if (!has_next) break;
#pragma unroll
        for (int a = 0; a < 2; ++a)
#pragma unroll
            for (int b = 0; b < 2; ++b)
#pragma unroll
                for (int m = 0; m < 4; ++m)
#pragma unroll
                    for (int n = 0; n < 2; ++n) acc[a][b][m][n] = (f32x4){0.f, 0.f, 0.f, 0.f};
        cur = nxt; cA = nA; cB = nB; ++ui;
        if constexpr (ALIGN_EPI) { if (wr == 1) PG8_BAR; }
    }
    PG8_WAIT_V(0);
    if constexpr (!ALIGN_EPI) { if (wr == 0) PG8_BAR; }
    PG8_BAR;
    if (E.drain()) { E.fused(acc, cur, wr, wc, fr, fq, lds, wid, lane); S.done(cur); }
#undef PG8_SO
#undef PG8_SA
#undef PG8_SB
#undef PG8_STAGE
#undef PG8_LDA
#undef PG8_LDB
#undef PG8_MMA
#undef PG8_WAIT_V
#undef PG8_WAIT_L
#undef PG8_BAR
#undef PG8_SCHED
}
}


typedef unsigned short bf16;
typedef pg8::bf16x8 bf16x8;
typedef pg8::f32x4 f32x4;
typedef pg8::u32x4 u32x4;
typedef unsigned u32x2 __attribute__((ext_vector_type(2)));
typedef float f32x2 __attribute__((ext_vector_type(2)));
constexpr int NTOK = 16384, DM = 1024, DFF = 2816;
constexpr int PW = 3584, GMW = 3072;
constexpr int UA_OFF = 0, Q_OFF = 512, F_OFF = 1024, V_OFF = 1536, G_OFF = 2048, XC_OFF = 2560, GC_OFF = 3072;
constexpr size_t MiB = 1u << 20;
constexpr size_t WS_LB = 0, WS_AR = 8192, WS_AI = 16384, WS_BBT = 65536, WS_CM = 512 * 1024, WS_DEC = 1 * MiB, WS_AGG = 2 * MiB, WS_SLOC = 4 * MiB,
                 WS_W = 8 * MiB, WS_HB = 28 * MiB, WS_PROJ = 60 * MiB, WS_R = 172 * MiB, WS_IX = 188 * MiB, WS_HGS = 204 * MiB, WS_GM = 172 * MiB, WS_ACT = 172 * MiB, WS_WI0 = 260 * MiB, WS_TEAM = 268 * MiB, WS_TEAMX = 268 * MiB + 475136, WS_SSQ = 268 * MiB + 524288, WS_END = 268 * MiB + 524288 + 262144;
constexpr size_t W_GU = 0, W_D = (size_t)7602176;
constexpr size_t W_GMW = 0, W_BP = (size_t)3072 * 1024, W_WO = W_BP + (size_t)3 * 1024 * 512, W_GLU = W_WO + (size_t)1024 * 1024;
static_assert((W_GLU + 512 * 512) <= W_D && (W_D + (size_t)1024 * 2816) * 2 <= 20 * MiB && (size_t)5632 * 1024 <= W_D, "W region");
constexpr int LDS_PHASE = 143360;
constexpr int LDS_BYTES = LDS_PHASE + 64;
constexpr size_t WS_BAR = 268 * MiB + 475136 + 1024;
constexpr size_t CTL_BYTES = 475136 + 1024 + 3456 * 4;
constexpr int NPH = 29;

typedef __bf16 bf16x2_t __attribute__((ext_vector_type(2)));
__device__ __forceinline__ unsigned pk2(float lo, float hi) { f32x2 v = {lo, hi}; bf16x2_t b = __builtin_convertvector(v, bf16x2_t); return __builtin_bit_cast(unsigned, b); }
__device__ __forceinline__ unsigned f2bf(float f) { return pk2(f, 0.f) & 0xffffu; }
__device__ __forceinline__ float bf2f(unsigned h) { return __builtin_bit_cast(float, h << 16); }
__device__ __forceinline__ float rcp_(float x) { return __builtin_amdgcn_rcpf(x); }
__device__ __forceinline__ float sigm(float x) { return rcp_(1.f + __expf(-x)); }
__device__ __forceinline__ float silu_(float x) { return x * sigm(x); }
__device__ __forceinline__ float gelu_(float x) { return x * sigm(1.5957691216057308f * (x + 0.044715f * x * x * x)); }
__device__ __forceinline__ void load8(const bf16* p, float (&v)[8]) {
    const u32x4 w = *(const u32x4*)p;
#pragma unroll
    for (int i = 0; i < 4; ++i) { v[2 * i] = __builtin_bit_cast(float, w[i] << 16); v[2 * i + 1] = __builtin_bit_cast(float, w[i] & 0xffff0000u); }
}
__device__ __forceinline__ void store8(bf16* p, const float (&v)[8]) {
    u32x4 w; w.x = pk2(v[0], v[1]); w.y = pk2(v[2], v[3]); w.z = pk2(v[4], v[5]); w.w = pk2(v[6], v[7]); *(u32x4*)p = w;
}
__device__ __forceinline__ float wave_sum(float v) {
#pragma unroll
    for (int o = 1; o < 64; o <<= 1) v += __shfl_xor(v, o);
    return v;
}
#define LBAR() do { asm volatile("s_waitcnt lgkmcnt(0)" ::: "memory"); __builtin_amdgcn_s_barrier(); asm volatile("" ::: "memory"); } while (0)
#define MFMA16(a, b, c) __builtin_amdgcn_mfma_f32_16x16x32_bf16((a), (b), (c), 0, 0, 0)

__device__ __forceinline__ void team_sync(unsigned* word, int tid, int same_xcd);
struct Epi {
    static constexpr bool PERM = true, AFTER_DRAIN = false;
    int mode; bf16* O; int ldc; float* X; const float* Xsrc; float scale; const bf16* aux; int ldaux; const float* vec; int first; float* ssq; unsigned* tword; int same;
    __device__ __forceinline__ bool drain() const { return mode == 6; }
    __device__ __forceinline__ void operator()(const f32x4 (&acc)[2][2][4][2], const pg8::Unit& u, int wr, int wc, int fr, int fq) const {
        const int row0 = u.pm * 256 + wr * 64 + fr, cl = wc * 32 + 8 * fq;
        if (mode == 0) {
#pragma unroll
            for (int ai = 0; ai < 2; ++ai)
#pragma unroll
                for (int m = 0; m < 4; ++m) { const int row = row0 + ai * 128 + m * 16; float v[8];
#pragma unroll
                    for (int n = 0; n < 2; ++n)
#pragma unroll
                        for (int j = 0; j < 4; ++j) v[n * 4 + j] = silu_(acc[ai][0][m][n][j]) * acc[ai][1][m][n][j];
                    store8(O + (size_t)row * ldc + u.pn * 128 + cl, v); }
        } else if (mode == 1) {
#pragma unroll
            for (int ai = 0; ai < 2; ++ai)
#pragma unroll
                for (int m = 0; m < 4; ++m) { const int row = row0 + ai * 128 + m * 16;
#pragma unroll
                    for (int bj = 0; bj < 2; ++bj) { const size_t off = (size_t)row * DM + u.pn * 256 + bj * 128 + cl; float* p = X + off; const float* ps = Xsrc + off;
#pragma unroll
                        for (int n = 0; n < 2; ++n) { f32x4 o = *(const f32x4*)(ps + 4 * n); o = o + acc[ai][bj][m][n] * scale; *(f32x4*)(p + 4 * n) = o; } } }
        } else if (mode == 2) {
            const int seg = u.pn >> 1;
#define PROJ_EPI(EXPR) \
            _Pragma("unroll") for (int bj = 0; bj < 2; ++bj) { const int c0 = u.pn * 256 + bj * 128 + cl; \
                _Pragma("unroll") for (int ai = 0; ai < 2; ++ai) _Pragma("unroll") for (int m = 0; m < 4; ++m) { const int row = row0 + ai * 128 + m * 16; float v[8]; \
                    _Pragma("unroll") for (int n = 0; n < 2; ++n) _Pragma("unroll") for (int j = 0; j < 4; ++j) { const float a = acc[ai][bj][m][n][j]; const int i8 = n * 4 + j; (void)i8; v[n * 4 + j] = (EXPR); } \
                    store8(O + (size_t)row * PW + c0, v); } }
            if (seg == 1 || seg == 4) { PROJ_EPI(silu_(a)) }
            else if (seg == 6) { PROJ_EPI(gelu_(a)) }
            else if (seg == 2) {
#pragma unroll
                for (int bj = 0; bj < 2; ++bj) { const int c0 = u.pn * 256 + bj * 128 + cl; float lb[8];
#pragma unroll
                    for (int i = 0; i < 8; ++i) lb[i] = vec[c0 - F_OFF + i];
#pragma unroll
                    for (int ai = 0; ai < 2; ++ai)
#pragma unroll
                        for (int m = 0; m < 4; ++m) { const int row = row0 + ai * 128 + m * 16; float v[8];
#pragma unroll
                            for (int i = 0; i < 8; ++i) { const float a = acc[ai][bj][m][i >> 2][i & 3]; v[i] = __logf(lb[i] + (1.f - lb[i]) * sigm(a)); }
                            store8(O + (size_t)row * PW + c0, v); } }
            } else { PROJ_EPI(a) }
#undef PROJ_EPI
        } else if (mode == 3) {
#pragma unroll
            for (int bj = 0; bj < 2; ++bj) { const int c0 = u.pn * 256 + bj * 128 + cl; float bb[8];
#pragma unroll
                for (int i = 0; i < 8; ++i) bb[i] = vec[c0 + i];
#pragma unroll
                for (int ai = 0; ai < 2; ++ai)
#pragma unroll
                    for (int m = 0; m < 4; ++m) { const int row = row0 + ai * 128 + m * 16; float z[8], v[8]; load8(aux + (size_t)row * ldaux + c0, z);
#pragma unroll
                        for (int n = 0; n < 2; ++n)
#pragma unroll
                            for (int j = 0; j < 4; ++j) v[n * 4 + j] = z[n * 4 + j] * sigm(acc[ai][bj][m][n][j] + bb[n * 4 + j]);
                        store8(O + (size_t)row * ldc + c0, v); } }
        } else if (mode == 4) {
#pragma unroll
            for (int bj = 0; bj < 2; ++bj) { const int c0 = u.pn * 256 + bj * 128 + cl;
#pragma unroll
                for (int ai = 0; ai < 2; ++ai)
#pragma unroll
                    for (int m = 0; m < 4; ++m) { const int row = row0 + ai * 128 + m * 16; float v[8];
#pragma unroll
                        for (int n = 0; n < 2; ++n)
#pragma unroll
                            for (int j = 0; j < 4; ++j) v[n * 4 + j] = sigm(acc[ai][bj][m][n][j]);
                        store8(O + (size_t)row * ldc + c0, v); } }
        } else {
            const bf16* gate = aux + (size_t)u.sg * DM; const int first_ = (u.sg == 0);
#pragma unroll
            for (int bj = 0; bj < 2; ++bj) { const int c0 = u.pn * 256 + bj * 128 + cl;
#pragma unroll
                for (int ai = 0; ai < 2; ++ai)
#pragma unroll
                    for (int m = 0; m < 4; ++m) { const int row = row0 + ai * 128 + m * 16; float gt[8], v[8]; load8(gate + (size_t)row * ldaux + c0, gt);
                        if (first_) {
#pragma unroll
                            for (int i = 0; i < 8; ++i) v[i] = 0.f; } else load8(O + (size_t)row * ldc + c0, v);
#pragma unroll
                        for (int n = 0; n < 2; ++n)
#pragma unroll
                            for (int j = 0; j < 4; ++j) v[n * 4 + j] += gt[n * 4 + j] * acc[ai][bj][m][n][j];
                        store8(O + (size_t)row * ldc + c0, v); } }
        }
    }
    __device__ __forceinline__ void fused(f32x4 (&acc)[2][2][4][2], const pg8::Unit& u, int wr, int wc, int fr, int fq, PG8_LAS unsigned char* lds, int wid, int lane) const {
        PG8_LAS float* P = (PG8_LAS float*)lds;
        const int row0 = u.pm * 256 + wr * 64 + fr, cl = wc * 32 + 8 * fq;
#pragma unroll
        for (int ai = 0; ai < 2; ++ai)
#pragma unroll
            for (int m = 0; m < 4; ++m) { const int row = row0 + ai * 128 + m * 16; float ss = 0.f;
#pragma unroll
                for (int bj = 0; bj < 2; ++bj) { const float* ps = Xsrc + (size_t)row * DM + u.pn * 256 + bj * 128 + cl;
#pragma unroll
                    for (int n = 0; n < 2; ++n) { f32x4 o = *(const f32x4*)(ps + 4 * n); o = o + acc[ai][bj][m][n] * scale; acc[ai][bj][m][n] = o; ss += (o.x * o.x + o.y * o.y) + (o.z * o.z + o.w * o.w); } }
                ss += __shfl_xor(ss, 16); ss += __shfl_xor(ss, 32);
                if (fq == 0) P[(ai * 128 + wr * 64 + m * 16 + fr) * 4 + wc] = ss;
                if (m & 1) asm volatile("" ::: "memory"); }
        __syncthreads();
        const int t = wid * 64 + lane;
        if (t < 256) { const float a = P[t * 4 + 0], b = P[t * 4 + 1], c = P[t * 4 + 2], d = P[t * 4 + 3]; ssq[(size_t)(u.pm * 256 + t) * 4 + u.pn] = (a + b) + (c + d); }
        team_sync(tword, t, same);
#pragma unroll
        for (int ai = 0; ai < 2; ++ai)
#pragma unroll
            for (int m = 0; m < 4; ++m) { const int row = row0 + ai * 128 + m * 16; const f32x4 q4 = *(const f32x4*)(ssq + (size_t)row * 4);
                const float rstd = __builtin_amdgcn_rsqf(((q4.x + q4.y) + (q4.z + q4.w)) * (1.f / DM) + 1e-6f);
#pragma unroll
                for (int bj = 0; bj < 2; ++bj) { const int col = u.pn * 256 + bj * 128 + cl; float* po = X + (size_t)row * DM + col;
#pragma unroll
                    for (int n = 0; n < 2; ++n) { const f32x4 wv = *(const f32x4*)(vec + col + 4 * n); *(f32x4*)(po + 4 * n) = acc[ai][bj][m][n] * rstd * wv; } } }
    }
};

typedef const __attribute__((address_space(1))) float* inptr_t;
typedef const __attribute__((address_space(4))) inptr_t* KArgP;
struct Ctx {
    KArgP kin; float* X; unsigned char* ws;
    __device__ __forceinline__ const float* in(int k) const { return (const float*)kin[k]; }
    float *LB, *AR, *AI, *DEC, *AGG, *SLOC; bf16 *BBT, *CM, *W, *HB, *PROJ, *R, *IX, *HGS, *GM;
};

__device__ __forceinline__ void norm_rows(const float* src, float* cpy, const float* w, bf16* dst, int gw, int NGW, int mend, int lane) {
    f32x4 wv[4];
#pragma unroll
    for (int j = 0; j < 4; ++j) wv[j] = ((const f32x4*)w)[lane + 64 * j];
    for (int m0 = gw; m0 < mend; m0 += 2 * NGW) {
        const int m1 = (m0 + NGW < mend) ? m0 + NGW : m0;
        const f32x4* xr0 = (const f32x4*)(src + (size_t)m0 * DM) + lane; const f32x4* xr1 = (const f32x4*)(src + (size_t)m1 * DM) + lane; f32x4 v[2][4]; float s0 = 0.f, s1 = 0.f;
#pragma unroll
        for (int j = 0; j < 4; ++j) { v[0][j] = xr0[64 * j]; v[1][j] = xr1[64 * j]; }
#pragma unroll
        for (int j = 0; j < 4; ++j) { s0 += (v[0][j].x * v[0][j].x + v[0][j].y * v[0][j].y) + (v[0][j].z * v[0][j].z + v[0][j].w * v[0][j].w);
                                      s1 += (v[1][j].x * v[1][j].x + v[1][j].y * v[1][j].y) + (v[1][j].z * v[1][j].z + v[1][j].w * v[1][j].w); }
        s0 = wave_sum(s0); s1 = wave_sum(s1);
#pragma unroll
        for (int rr = 0; rr < 2; ++rr) { const int m = rr ? m1 : m0; if (rr && m1 == m0) break; const float rstd = __builtin_amdgcn_rsqf((rr ? s1 : s0) * (1.f / DM) + 1e-6f);
            if (cpy) { f32x4* c = (f32x4*)(cpy + (size_t)m * DM) + lane;
#pragma unroll
                for (int j = 0; j < 4; ++j) c[64 * j] = v[rr][j]; }
            u32x2* o = (u32x2*)(dst + (size_t)m * DM) + lane;
#pragma unroll
            for (int j = 0; j < 4; ++j) { u32x2 pp; pp.x = pk2(v[rr][j].x * rstd * wv[j].x, v[rr][j].y * rstd * wv[j].y); pp.y = pk2(v[rr][j].z * rstd * wv[j].z, v[rr][j].w * rstd * wv[j].w); o[64 * j] = pp; } }
    }
}
__device__ __forceinline__ void final_norm_rows(float* X, const float* w, int gw, int NGW, int mend, int lane) {
    f32x4 wv[4];
#pragma unroll
    for (int j = 0; j < 4; ++j) wv[j] = ((const f32x4*)w)[lane + 64 * j];
    for (int m = gw; m < mend; m += NGW) {
        f32x4* xr = (f32x4*)(X + (size_t)m * DM) + lane; f32x4 v[4]; float s = 0.f;
#pragma unroll
        for (int j = 0; j < 4; ++j) { v[j] = xr[64 * j]; s += (v[j].x * v[j].x + v[j].y * v[j].y) + (v[j].z * v[j].z + v[j].w * v[j].w); }
        s = wave_sum(s); const float rstd = __builtin_amdgcn_rsqf(s * (1.f / DM) + 1e-6f);
#pragma unroll
        for (int j = 0; j < 4; ++j) xr[64 * j] = v[j] * rstd * wv[j];
    }
}
__device__ __forceinline__ void transpose_item(const float* W, int N, bf16* WT, int ldt, int k0, int n0, int dst_row0, float* scr, int lane) {
    float rg_[32];
#pragma unroll
    for (int i = 0; i < 32; ++i) rg_[i] = W[(size_t)(k0 + 2 * i + (lane >> 5)) * N + n0 + (lane & 31)];
#pragma unroll
    for (int i = 0; i < 32; ++i) scr[(2 * i + (lane >> 5)) * 33 + (lane & 31)] = rg_[i];
    asm volatile("s_waitcnt lgkmcnt(0)" ::: "memory");
    const int c = lane & 7;
#pragma unroll
    for (int j = 0; j < 4; ++j) { const int n = (lane >> 3) + 8 * j; const float* s = scr + (8 * c) * 33 + n;
        u32x4 o; o.x = pk2(s[0 * 33], s[1 * 33]); o.y = pk2(s[2 * 33], s[3 * 33]); o.z = pk2(s[4 * 33], s[5 * 33]); o.w = pk2(s[6 * 33], s[7 * 33]);
        *(u32x4*)(WT + (size_t)(dst_row0 + n) * ldt + k0 + 8 * c) = o; }
    asm volatile("s_waitcnt lgkmcnt(0)" ::: "memory");
}
__device__ __forceinline__ void convert_ffn(const Ctx& C, int l, int j, float* scr, int gw, int NGW, int lane, int part) {
    const float* Wg = C.in(3) + (size_t)(l * 2 + j) * DM * DFF; const float* Wu = C.in(4) + (size_t)(l * 2 + j) * DM * DFF; const float* Wd = C.in(5) + (size_t)(l * 2 + j) * DFF * DM;
    for (int it = (part ? 2816 : 0) + gw; it < (part ? 3 * 1408 : 2816); it += NGW) {
        if (it < 2816) { const int up = it >= 1408, r = it - up * 1408, kb = r / 88, nb = r % 88, n0 = 32 * nb;
            transpose_item(up ? Wu : Wg, DFF, C.W + W_GU, DM, 64 * kb, n0, (n0 >> 7) * 256 + (n0 & 127) + up * 128, scr, lane); }
        else { const int r = it - 2816, kb = r >> 5, nb = r & 31; transpose_item(Wd, DM, C.W + W_D, DFF, 64 * kb, 32 * nb, 32 * nb, scr, lane); }
    }
}
__device__ __forceinline__ void convert_mixer(const Ctx& C, int l, float* scr, int gw, int NGW, int lane, int part) {
    if (part == 0) {
        for (int r = gw; r < 1792; r += NGW) { const int kb = r / 112, nb = r % 112; transpose_item(C.in(6) + (size_t)l * DM * 6656, 6656, (bf16*)(C.ws + WS_WI0), DM, 64 * kb, 32 * nb, 32 * nb, scr, lane); }
        return;
    }
    for (int it = gw; it < 1536 + 768 + 512 + 128; it += NGW) {
        int r = it;
        if (r < 1536) { const int kb = r / 96, nb = 112 + r % 96; transpose_item(C.in(6) + (size_t)l * DM * 6656, 6656, C.W + W_GMW, DM, 64 * kb, 32 * nb, 32 * nb - PW, scr, lane); continue; } r -= 1536;
        if (r < 768) { const int n = r >> 8, q = r & 255, kb = q >> 5, nb = q & 31; transpose_item(C.in(7) + (size_t)(l * 3 + n) * 512 * DM, DM, C.W + W_BP + (size_t)n * DM * 512, 512, 64 * kb, 32 * nb, 32 * nb, scr, lane); continue; } r -= 768;
        if (r < 512) { const int kb = r >> 5, nb = r & 31; transpose_item(C.in(8) + (size_t)l * DM * DM, DM, C.W + W_WO, DM, 64 * kb, 32 * nb, 32 * nb, scr, lane); continue; } r -= 512;
        { const int kb = r >> 4, nb = r & 15; transpose_item(C.in(17) + (size_t)l * 512 * 512, 512, C.W + W_GLU, 512, 64 * kb, 32 * nb, 32 * nb, scr, lane); }
    }
}
__device__ __forceinline__ void make_tables(const Ctx& C, int l, int gtid) {
    if (gtid < 2048) {
        const int g = gtid >> 6, p = gtid & 63, gp = (l * 32 + g) * 64 + p;
        const float lr = fminf(C.in(9)[gp], -1e-4f), li = C.in(10)[gp], dt = expf(C.in(11)[l * 32 + g]);
        const float mag = expf(lr * dt); float sn, cs; sincosf(li * dt, &sn, &cs);
        const float ar = mag * cs, ai = mag * sn, den = lr * lr + li * li;
        const float fr = ((ar - 1.0f) * lr + ai * li) / den, fi = (ai * lr - (ar - 1.0f) * li) / den;
        C.AR[gtid] = ar; C.AI[gtid] = ai;
        const float* br = C.in(12) + (size_t)gp * 16; const float* bi = C.in(13) + (size_t)gp * 16;
        bf16* o_re = C.BBT + ((size_t)(g * 128 + p)) * 32; bf16* o_im = C.BBT + ((size_t)(g * 128 + 64 + p)) * 32;
        for (int c = 0; c < 16; ++c) { const float b_r = br[c], b_i = bi[c]; o_re[c] = (bf16)f2bf(fr * b_r - fi * b_i); o_im[c] = (bf16)f2bf(fr * b_i + fi * b_r); }
        { unsigned z = 0u; asm volatile("" : "+v"(z)); const u32x4 zz = {z, z, z, z};
          *(u32x4*)(o_re + 16) = zz; *(u32x4*)(o_re + 24) = zz; *(u32x4*)(o_im + 16) = zz; *(u32x4*)(o_im + 24) = zz; }
        for (int c = 0; c < 16; ++c) { const size_t ci = ((size_t)((l * 32 + g) * 16 + c)) * 64 + p;
            C.CM[((size_t)(g * 16 + c)) * 128 + p] = (bf16)f2bf(C.in(14)[ci]); C.CM[((size_t)(g * 16 + c)) * 128 + 64 + p] = (bf16)f2bf(-C.in(15)[ci]); }
    } else if (gtid < 2560) {
        const int d = gtid - 2048; const float a0 = C.in(19)[d], a1 = C.in(19)[512 + d], mx = fmaxf(a0, a1), e0 = expf(a0 - mx), e1 = expf(a1 - mx);
        const float p0 = e0 / (e0 + e1), p1 = e1 / (e0 + e1);
        C.LB[d] = (l == 0) ? (p0 - p0) : ((p0 + p1) - p0);
    }
}

__device__ __forceinline__ void rg1_load(const Ctx& C, int item, int tid, unsigned (&xw)[5]) {
    const int cidx = item >> 3, h = item & 7, t0 = cidx * 64, j = cidx & 63;
#pragma unroll
    for (int k = 0; k < 5; ++k) { const int i = tid + 512 * k, row = i >> 5, cp = i & 31; xw[k] = 0u;
        if (i < 67 * 32 && !(j == 0 && row < 3)) xw[k] = *(const unsigned*)(C.PROJ + (size_t)(t0 - 3 + row) * PW + XC_OFF + h * 64 + 2 * cp); }
}
__device__ __forceinline__ void rg1_item(const Ctx& C, unsigned char* lds, int l, int item, int tid, int wave, int lane, bool stage_w, unsigned (&xw)[5], int next_item) {
    const int cidx = item >> 3, h = item & 7, t0 = cidx * 64, j = cidx & 63, q = lane >> 4, r16 = lane & 15;
    float* XIN = (float*)lds; float* XCF = (float*)(lds + 17152); bf16* AT = (bf16*)(lds + 33536); bf16* BT = (bf16*)(lds + 42752); float* G = (float*)(lds + 61184);
    const int cc = tid & 63, chh = h * 64 + cc;
    { float bw[16];
      if (stage_w) { const int n = tid & 127; const float* wsrc = (n < 64 ? C.in(23) : C.in(25)) + ((size_t)((l * 8 + h) * 64)) * 64 + (n & 63);
#pragma unroll
        for (int k = 0; k < 16; ++k) bw[k] = wsrc[(size_t)((tid >> 7) + 4 * k) * 64];
#pragma unroll
        for (int k = 0; k < 16; ++k) BT[n * 72 + (tid >> 7) + 4 * k] = (bf16)f2bf(bw[k]); }
#pragma unroll
      for (int k = 0; k < 5; ++k) { const int i = tid + 512 * k, row = i >> 5, cp = i & 31; if (i < 67 * 32) { XIN[row * 64 + 2 * cp] = bf2f(xw[k] & 0xffffu); XIN[row * 64 + 2 * cp + 1] = bf2f(xw[k] >> 16); } } }
    const float cb_ = C.in(22)[l * 512 + chh], cw0 = C.in(21)[(l * 4 + 0) * 512 + chh], cw1 = C.in(21)[(l * 4 + 1) * 512 + chh], cw2 = C.in(21)[(l * 4 + 2) * 512 + chh], cw3 = C.in(21)[(l * 4 + 3) * 512 + chh];
    const float ba_ = C.in(24)[l * 512 + chh], bx_ = C.in(26)[l * 512 + chh];
    LBAR();
    if (next_item < 2048) rg1_load(C, next_item, tid, xw);
#pragma unroll
    for (int k = 0; k < 8; ++k) { const int t = (tid >> 6) + 8 * k, c = cc;
        const float xc = cb_ + cw0 * XIN[t * 64 + c] + cw1 * XIN[(t + 1) * 64 + c] + cw2 * XIN[(t + 2) * 64 + c] + cw3 * XIN[(t + 3) * 64 + c];
        XCF[t * 64 + c] = xc; AT[t * 72 + c] = (bf16)f2bf(xc); }
    LBAR();
    { bf16x8 bfr[2];
#pragma unroll
      for (int k = 0; k < 2; ++k) bfr[k] = *(const bf16x8*)(BT + (wave * 16 + r16) * 72 + k * 32 + q * 8);
#pragma unroll
      for (int tm = 0; tm < 4; ++tm) { f32x4 acc = {0.f, 0.f, 0.f, 0.f};
#pragma unroll
          for (int k = 0; k < 2; ++k) { const bf16x8 a = *(const bf16x8*)(AT + (tm * 16 + r16) * 72 + k * 32 + q * 8); acc = MFMA16(a, bfr[k], acc); }
#pragma unroll
          for (int jj = 0; jj < 4; ++jj) G[(tm * 16 + 4 * q + jj) * 129 + wave * 16 + r16] = acc[jj]; } }
    LBAR();
#pragma unroll
    for (int k = 0; k < 8; ++k) { const int t = (tid >> 6) + 8 * k, c = cc, ch = chh;
        const float r = sigm(G[t * 129 + c] + ba_), ig = sigm(G[t * 129 + 64 + c] + bx_);
        const unsigned rb = f2bf(r), ixb = f2bf(ig * XCF[t * 64 + c]);
        C.R[(size_t)(t0 + t) * 512 + ch] = (bf16)rb; C.IX[(size_t)(t0 + t) * 512 + ch] = (bf16)ixb;
        G[t * 129 + c] = bf2f(rb); G[t * 129 + 64 + c] = bf2f(ixb); }
    LBAR();
    { const int c = tid & 63, sg = tid >> 6, ch = h * 64 + c; const float sp8 = -8.0f * log1pf(expf(-C.in(27)[l * 512 + ch])); float A = 1.f, B = 0.f;
#pragma unroll
      for (int tt = 0; tt < 8; ++tt) { const int t = sg * 8 + tt; const float a = __expf(sp8 * G[t * 129 + c]), bb = __builtin_amdgcn_sqrtf(fmaxf(1.f - a * a, 0.f)) * G[t * 129 + 64 + c]; A *= a; B = a * B + bb; }
      XCF[(sg * 64 + c) * 2] = A; XCF[(sg * 64 + c) * 2 + 1] = B; }
    LBAR();
    if (tid < 64) { const int c = tid, ch = h * 64 + c; float A = 1.f, B = 0.f;
#pragma unroll
        for (int sg = 0; sg < 8; ++sg) { const float a = XCF[(sg * 64 + c) * 2], bb = XCF[(sg * 64 + c) * 2 + 1]; A *= a; B = a * B + bb; }
        f32x2 o; o.x = A; o.y = B; *(f32x2*)(C.AGG + ((size_t)cidx * 512 + ch) * 2) = o; }
    LBAR();
}
__device__ __forceinline__ void rgc_item(const Ctx& C, int l, int cidx, int tid) {
    const int b = cidx >> 6, j = cidx & 63, c = tid; float hst = 0.f;
    { const float* ag = C.AGG + ((size_t)(b * 64) * 512 + c) * 2;
      for (int i0 = 0; i0 < j; i0 += 16) {
          f32x2 ab[16];
#pragma unroll
          for (int k = 0; k < 16; ++k) ab[k] = *(const f32x2*)(ag + (size_t)(i0 + k) * 1024);
#pragma unroll
          for (int k = 0; k < 16; ++k) if (i0 + k < j) hst = ab[k].x * hst + ab[k].y; } }
    const float sp8 = -8.0f * log1pf(expf(-C.in(27)[l * 512 + c]));
    const bf16* rp = C.R + (size_t)cidx * 64 * 512 + c; const bf16* ip = C.IX + (size_t)cidx * 64 * 512 + c; bf16* gp = C.PROJ + (size_t)cidx * 64 * PW + GC_OFF + c;
#pragma unroll 32
    for (int t = 0; t < 64; ++t) {
        const float r = bf2f(rp[t * 512]), ix = bf2f(ip[t * 512]), gc = bf2f(gp[(size_t)t * PW]);
        const float a = __expf(sp8 * r), bb = __builtin_amdgcn_sqrtf(fmaxf(1.f - a * a, 0.f)) * ix;
        hst = a * hst + bb; gp[(size_t)t * PW] = (bf16)f2bf(hst * gc); }
}

template <bool FINAL>
__device__ __forceinline__ void s5_chunk(const Ctx& C, unsigned char* lds, int l, int item, int tid, int wave, int lane) {
    const int cidx = item >> 1, hf = item & 1, t0 = cidx * 128, q = lane >> 4, r16 = lane & 15, b = cidx >> 5, j = cidx & 31;
    bf16* UT = (bf16*)lds; float* BU = (float*)(lds + 34816) + wave * (16 * 132); bf16* XS = (bf16*)(lds + 34816 + 8 * 16 * 132 * 4) + wave * (16 * 136);
    u32x4 uw[4];
#pragma unroll
    for (int k = 0; k < 4; ++k) { const int i = tid + 512 * k, t = i >> 4, ck = i & 15; uw[k] = *(const u32x4*)(C.PROJ + (size_t)(t0 + t) * PW + UA_OFF + (2 * hf) * 128 + ck * 8); }
    for (int pp = 0; pp < 2; ++pp) {
        const int go = 2 * hf + pp, g = go * 8 + wave;
        f32x2 cs[32];
        if (FINAL) { const float* sl = C.SLOC + ((size_t)((b * 32) * 32 + g) * 64 + lane) * 2;
#pragma unroll
            for (int i = 0; i < 32; ++i) cs[i] = *(const f32x2*)(sl + (size_t)i * 4096); }
        float dsk[4];
        if (FINAL) {
#pragma unroll
            for (int jj = 0; jj < 4; ++jj) dsk[jj] = C.in(16)[l * 512 + g * 16 + 4 * q + jj]; }
        bf16x8 bfr[8];
#pragma unroll
        for (int tn = 0; tn < 8; ++tn) bfr[tn] = *(const bf16x8*)(C.BBT + ((size_t)(g * 128 + tn * 16 + r16)) * 32 + q * 8);
        const float ar = C.AR[g * 64 + lane], ai = C.AI[g * 64 + lane]; float xr = 0.f, xi = 0.f;
        bf16x8 cfr[4];
        if (FINAL) {
#pragma unroll
            for (int k = 0; k < 4; ++k) cfr[k] = *(const bf16x8*)(C.CM + ((size_t)(g * 16 + r16)) * 128 + k * 32 + q * 8); }
#pragma unroll
        for (int k = 0; k < 4; ++k) { const int i = tid + 512 * k, t = i >> 4, ck = i & 15; *(u32x4*)(UT + t * 136 + ck * 8) = uw[k]; }
        LBAR();
        if (FINAL) {
            float tr = ar, ti = ai;
#pragma unroll
            for (int s = 0; s < 7; ++s) { const float nr = tr * tr - ti * ti, ni = 2.f * tr * ti; tr = nr; ti = ni; }
#pragma unroll
            for (int i = 0; i < 32; ++i) if (i < j) { const float nr = tr * xr - ti * xi + cs[i].x, ni = tr * xi + ti * xr + cs[i].y; xr = nr; xi = ni; }
        }
        if (pp == 0) {
#pragma unroll
            for (int k = 0; k < 4; ++k) { const int i = tid + 512 * k, t = i >> 4, ck = i & 15; uw[k] = *(const u32x4*)(C.PROJ + (size_t)(t0 + t) * PW + UA_OFF + (go + 1) * 128 + ck * 8); }
        }
        for (int tm = 0; tm < 8; ++tm) {
            bf16x8 af = {0, 0, 0, 0, 0, 0, 0, 0}; if (q < 2) af = *(const bf16x8*)(UT + (tm * 16 + r16) * 136 + wave * 16 + q * 8);
#pragma unroll
            for (int tn = 0; tn < 8; ++tn) { f32x4 acc = {0.f, 0.f, 0.f, 0.f}; acc = MFMA16(af, bfr[tn], acc);
#pragma unroll
                for (int jj = 0; jj < 4; ++jj) BU[(4 * q + jj) * 132 + tn * 16 + r16] = acc[jj]; }
            LBAR();
#pragma unroll
            for (int tt = 0; tt < 16; ++tt) { const float bur = BU[tt * 132 + lane], bui = BU[tt * 132 + 64 + lane];
                const float nr = ar * xr - ai * xi + bur, ni = ar * xi + ai * xr + bui; xr = nr; xi = ni;
                if (FINAL) { XS[tt * 136 + lane] = (bf16)f2bf(xr); XS[tt * 136 + 64 + lane] = (bf16)f2bf(xi); } }
            LBAR();
            if (FINAL) {
                f32x4 acc = {0.f, 0.f, 0.f, 0.f};
#pragma unroll
                for (int k = 0; k < 4; ++k) { const bf16x8 xb = *(const bf16x8*)(XS + r16 * 136 + k * 32 + q * 8); acc = MFMA16(cfr[k], xb, acc); }
                const int t = tm * 16 + r16; const bf16* up = UT + t * 136 + wave * 16 + 4 * q; float v[4];
#pragma unroll
                for (int jj = 0; jj < 4; ++jj) v[jj] = gelu_(acc[jj] + dsk[jj] * bf2f(up[jj]));
                u32x2 o; o.x = pk2(v[0], v[1]); o.y = pk2(v[2], v[3]); *(u32x2*)(C.PROJ + (size_t)(t0 + t) * PW + UA_OFF + g * 16 + 4 * q) = o;
            }
        }
        if (!FINAL) { f32x2 o; o.x = xr; o.y = xi; *(f32x2*)(C.SLOC + ((size_t)(cidx * 32 + g) * 64 + lane) * 2) = o; }
        LBAR();
    }
}

__device__ __forceinline__ void hg_stage(const Ctx& C, unsigned char* lds, int t0, int h, int tid, float (&lfr)[16], float (&bcv)[16]) {
    float* BC = (float*)lds; bf16* VT = (bf16*)(lds + 33024); float* TOT = (float*)(lds + 33024 + 18432);
    { const int d = tid & 127, qt = tid >> 7; const bf16* p = C.PROJ + (size_t)(t0 + qt * 16) * PW + F_OFF + h * 128 + d; float loc[16]; float run = 0.f;
#pragma unroll
      for (int i = 0; i < 16; ++i) { loc[i] = bf2f(p[(size_t)i * PW]); lfr[i] = loc[i]; }
#pragma unroll
      for (int i = 0; i < 16; ++i) { run += loc[i]; loc[i] = run; }
      TOT[qt * 128 + d] = run;
      unsigned vw[8];
#pragma unroll
      for (int k = 0; k < 8; ++k) { const int i = tid + 512 * k, s = i >> 6, ep = i & 63; vw[k] = *(const unsigned*)(C.PROJ + (size_t)(t0 + s) * PW + V_OFF + h * 128 + 2 * ep); }
#pragma unroll
      for (int k = 0; k < 8; ++k) { const int i = tid + 512 * k, s = i >> 6, ep = i & 63; VT[(2 * ep) * 72 + s] = (bf16)(vw[k] & 0xffffu); VT[(2 * ep + 1) * 72 + s] = (bf16)(vw[k] >> 16); }
      LBAR();
      float off = 0.f;
      for (int qq = 0; qq < qt; ++qq) off += TOT[qq * 128 + d];
#pragma unroll
      for (int i = 0; i < 16; ++i) { bcv[i] = loc[i] + off; BC[(qt * 16 + i) * 128 + d] = bcv[i]; } }
    LBAR();
}
__device__ __forceinline__ void hg1_item(const Ctx& C, unsigned char* lds, int item, int tid, int wave, int lane) {
    const int cidx = item >> 2, h = item & 3, t0 = cidx * 64, q = lane >> 4, r16 = lane & 15;
    float* BC = (float*)lds; bf16* VT = (bf16*)(lds + 33024); bf16* KT = (bf16*)(lds + 33024 + 18432);
    float lfr[16], bcv[16];
    hg_stage(C, lds, t0, h, tid, lfr, bcv);
    { const int d = tid & 127, qt = tid >> 7; const float bl = BC[63 * 128 + d];
#pragma unroll
      for (int i = 0; i < 16; ++i) { const int s = qt * 16 + i; const float kh = (1.f - __expf(lfr[i])) * __expf(bl - bcv[i]); KT[d * 72 + s] = (bf16)f2bf(kh); }
      if (qt == 3) C.DEC[(size_t)item * 128 + d] = __expf(bl); }
    LBAR();
    bf16x8 vf[2];
#pragma unroll
    for (int k = 0; k < 2; ++k) vf[k] = *(const bf16x8*)(VT + (wave * 16 + r16) * 72 + k * 32 + q * 8);
#pragma unroll
    for (int tm = 0; tm < 8; ++tm) { f32x4 acc = {0.f, 0.f, 0.f, 0.f};
#pragma unroll
        for (int k = 0; k < 2; ++k) { const bf16x8 kf = *(const bf16x8*)(KT + (tm * 16 + r16) * 72 + k * 32 + q * 8); acc = MFMA16(kf, vf[k], acc); }
        u32x2 o; o.x = pk2(acc[0], acc[1]); o.y = pk2(acc[2], acc[3]);
        *(u32x2*)(C.HGS + ((size_t)item * 128 + wave * 16 + r16) * 128 + tm * 16 + 4 * q) = o; }
    LBAR();
}
__device__ __forceinline__ void hg2_elem(const Ctx& C, int idx) {
    const int dp = idx & 63, e = (idx >> 6) & 127, h = (idx >> 13) & 3, b = idx >> 15; float s0 = 0.f, s1 = 0.f;
#pragma unroll 32
    for (int j = 0; j < 64; ++j) { const size_t item = (size_t)(b * 64 + j) * 4 + h; unsigned* p = (unsigned*)(C.HGS + (item * 128 + e) * 128 + 2 * dp);
        const f32x2 dc = *(const f32x2*)(C.DEC + item * 128 + 2 * dp); const unsigned w = *p; *p = pk2(s0, s1);
        s0 = dc.x * s0 + bf2f(w & 0xffffu); s1 = dc.y * s1 + bf2f(w >> 16); }
}
__device__ __forceinline__ void hg3_item(const Ctx& C, unsigned char* lds, int l, int item, int tid, int wave, int lane) {
    const int cidx = item >> 2, h = item & 3, t0 = cidx * 64, q = lane >> 4, r16 = lane & 15;
    float* BC = (float*)lds; float* OF = (float*)lds; bf16* VT = (bf16*)(lds + 33024); bf16* QB = (bf16*)(lds + 51456); bf16* QT = (bf16*)(lds + 68864);
    bf16* K0 = (bf16*)(lds + 86272); bf16* K1 = (bf16*)(lds + 94976); bf16* P = (bf16*)(lds + 112384);
    bf16x8 sf[4];
#pragma unroll
    for (int k = 0; k < 4; ++k) sf[k] = *(const bf16x8*)(C.HGS + ((size_t)item * 128 + wave * 16 + r16) * 128 + k * 32 + q * 8);
    float qv_[16], lfr[16], bcv[16];
    { const int d = tid & 127, qt = tid >> 7; const bf16* pr = C.PROJ + (size_t)(t0 + qt * 16) * PW + Q_OFF + h * 128 + d;
#pragma unroll
      for (int i = 0; i < 16; ++i) qv_[i] = bf2f(pr[(size_t)i * PW]); }
    hg_stage(C, lds, t0, h, tid, lfr, bcv);
    { const int d = tid & 127, qt = tid >> 7; const float r1 = BC[31 * 128 + d];
#pragma unroll
      for (int i = 0; i < 16; ++i) { const int t = qt * 16 + i;
        const float qv = qv_[i], bt = bcv[i], kv = (1.f - __expf(lfr[i]));
        QB[t * 136 + d] = (bf16)f2bf(qv * __expf(bt)); QT[t * 136 + d] = (bf16)f2bf(qv * __expf(bt - (qt >= 2 ? r1 : 0.f)));
        if (qt < 2) K0[t * 136 + d] = (bf16)f2bf(kv * __expf(fminf(-bt, 80.f)));
        K1[t * 136 + d] = (bf16)f2bf(kv * __expf(fminf(r1 - bt, 80.f))); } }
    for (int i = tid; i < 1024; i += 512) P[(i >> 5) * 72 + 32 + (i & 31)] = 0;
    LBAR();
    for (int tile = wave; tile < 12; tile += 8) { int tm, tn; const bf16* KB;
        if (tile < 4) { tm = tile >> 1; tn = tile & 1; KB = K0; } else { const int tt = tile - 4; tm = 2 + (tt >> 2); tn = tt & 3; KB = K1; }
        f32x4 acc = {0.f, 0.f, 0.f, 0.f};
#pragma unroll
        for (int k = 0; k < 4; ++k) { const bf16x8 a = *(const bf16x8*)(QT + (tm * 16 + r16) * 136 + k * 32 + q * 8); const bf16x8 bb = *(const bf16x8*)(KB + (tn * 16 + r16) * 136 + k * 32 + q * 8); acc = MFMA16(a, bb, acc); }
        const int s = tn * 16 + r16;
#pragma unroll
        for (int jj = 0; jj < 4; ++jj) { const int t = tm * 16 + 4 * q + jj; P[t * 72 + s] = (s <= t) ? (bf16)f2bf(acc[jj]) : (bf16)0; } }
    LBAR();
    { bf16x8 vf[2];
#pragma unroll
      for (int k = 0; k < 2; ++k) vf[k] = *(const bf16x8*)(VT + (wave * 16 + r16) * 72 + k * 32 + q * 8);
#pragma unroll
      for (int tm = 0; tm < 4; ++tm) { f32x4 acc = {0.f, 0.f, 0.f, 0.f};
#pragma unroll
          for (int k = 0; k < 4; ++k) { const bf16x8 a = *(const bf16x8*)(QB + (tm * 16 + r16) * 136 + k * 32 + q * 8); acc = MFMA16(a, sf[k], acc); }
#pragma unroll
          for (int k = 0; k < 2; ++k) { const bf16x8 a = *(const bf16x8*)(P + (tm * 16 + r16) * 72 + k * 32 + q * 8); acc = MFMA16(a, vf[k], acc); }
#pragma unroll
          for (int jj = 0; jj < 4; ++jj) OF[(tm * 16 + 4 * q + jj) * 129 + wave * 16 + r16] = acc[jj]; } }
    LBAR();
    { const int t = tid >> 3, e0 = (tid & 7) * 16; float o[16], ss = 0.f;
#pragma unroll
      for (int i = 0; i < 16; ++i) { o[i] = OF[t * 129 + e0 + i]; ss += o[i] * o[i]; }
      ss += __shfl_xor(ss, 1); ss += __shfl_xor(ss, 2); ss += __shfl_xor(ss, 4);
      const float rstd = __builtin_amdgcn_rsqf(ss * (1.f / 128.f) + 1e-6f);
      bf16* row = C.PROJ + (size_t)(t0 + t) * PW + h * 128 + e0; const float* nw = C.in(20) + l * 512 + h * 128 + e0;
#pragma unroll
      for (int hf = 0; hf < 2; ++hf) { float gg[8], v[8]; load8(row + G_OFF + hf * 8, gg);
#pragma unroll
          for (int i = 0; i < 8; ++i) v[i] = o[hf * 8 + i] * rstd * nw[hf * 8 + i] * gg[i];
          store8(row + Q_OFF + hf * 8, v); } }
    LBAR();
}

#define LAS __attribute__((address_space(3)))
#define XB_TMO      128
#define XB_XCNT(j)  (256  + 64 * (j))
#define XB_XSUB(j)  (1280 + 64 * (j))
#define XB_XGEN(j)  (2304 + 64 * (j))
#define XB_TOP      3328
#define XB_TOPGEN   3392
#define XCD_BAR_WORDS 3456
#define XB_SPIN_CAP (1u << 18)

__device__ __forceinline__ unsigned xb_ld(unsigned* p)              { return __hip_atomic_load(p, __ATOMIC_RELAXED, __HIP_MEMORY_SCOPE_AGENT); }
__device__ __forceinline__ unsigned xb_add(unsigned* p, unsigned v) { return __hip_atomic_fetch_add(p, v, __ATOMIC_RELAXED, __HIP_MEMORY_SCOPE_AGENT); }
__device__ __forceinline__ unsigned xb_xcc_id() { return (unsigned)__builtin_amdgcn_s_getreg((3 << 11) | 20) & 0xFu; }
#define XB_SPIN(cond, bar) do { unsigned _sp = 0; while (cond) { __builtin_amdgcn_s_sleep(1); \
    if ((++_sp & 255u) == 0u) { if (xb_ld(&(bar)[XB_TMO])) break; if (_sp > XB_SPIN_CAP) { atomicAdd(&(bar)[XB_TMO], 1u); break; } } } } while (0)

struct XcdBarrier {
    unsigned* bar; unsigned x;
    volatile LAS unsigned* st;
};

__device__ __forceinline__ XcdBarrier xcd_barrier_post(unsigned* bar, volatile LAS unsigned* st) {
    XcdBarrier b; b.bar = bar; b.x = xb_xcc_id(); b.st = st;
    if (threadIdx.x == 0) (void)xb_add(&bar[XB_XCNT(b.x)], 1u);
    return b;
}
__device__ __forceinline__ void xcd_barrier_complete(unsigned* bar, unsigned x, unsigned& nloc, unsigned& nx) {
    const unsigned G = gridDim.x * gridDim.y * gridDim.z;
    unsigned sum, cnt, mine, sp = 0u;
    for (;;) {
        sum = 0u; cnt = 0u; mine = 0u;
#pragma unroll
        for (unsigned j = 0; j < 16; ++j) { const unsigned c = xb_ld(&bar[XB_XCNT(j)]); sum += c; cnt += (c > 0u) ? 1u : 0u; mine = (j == x) ? c : mine; }
        if (sum == G) break;
        __builtin_amdgcn_s_sleep(1);
        if ((++sp & 255u) == 0u) { if (xb_ld(&bar[XB_TMO])) break; if (sp > XB_SPIN_CAP) { atomicAdd(&bar[XB_TMO], 1u); break; } }
    }
    nloc = mine > 0u ? mine : 1u; nx = cnt > 0u ? cnt : 1u;
}

__device__ __forceinline__ void xcd_barrier(const XcdBarrier& b) {
    asm volatile("s_waitcnt vmcnt(0)" ::: "memory");
    __syncthreads();
    if (threadIdx.x == 0) {
        unsigned* bar = b.bar;
        __builtin_amdgcn_s_waitcnt(0);
        unsigned nloc = b.st[0], nx = b.st[1];
        if (nloc == 0u) { xcd_barrier_complete(bar, b.x, nloc, nx); b.st[0] = nloc; b.st[1] = nx; }
        const unsigned old = xb_add(&bar[XB_XSUB(b.x)], 1u);
        const unsigned gen = old / nloc;
        if (old + 1u == (gen + 1u) * nloc) {
            __builtin_amdgcn_fence(__ATOMIC_RELEASE, "agent");
            asm volatile("s_waitcnt vmcnt(0)" ::: "memory");
            const unsigned og = xb_add(&bar[XB_TOP], 1u);
            const unsigned tg = og / nx;
            if (og + 1u == (tg + 1u) * nx) xb_add(&bar[XB_TOPGEN], 1u);
            else XB_SPIN(xb_ld(&bar[XB_TOPGEN]) == tg, bar);
            __builtin_amdgcn_fence(__ATOMIC_ACQUIRE, "agent");
            xb_add(&bar[XB_XGEN(b.x)], 1u);
            asm volatile("s_waitcnt vmcnt(0)" ::: "memory");
        } else {
            XB_SPIN(xb_ld(&bar[XB_XGEN(b.x)]) == gen, bar);
            __builtin_amdgcn_fence(__ATOMIC_ACQUIRE, "agent");
            asm volatile("s_waitcnt vmcnt(0)" ::: "memory");
        }
    }
    __syncthreads();
}

__device__ __forceinline__ void team_sync(unsigned* word, int tid, int same_xcd) {
    asm volatile("s_waitcnt vmcnt(0)" ::: "memory");
    __syncthreads();
    if (tid == 0) {
        if (!same_xcd) { __builtin_amdgcn_fence(__ATOMIC_RELEASE, "agent"); asm volatile("s_waitcnt vmcnt(0)" ::: "memory"); }
        (void)xb_add(word, 1u);
        unsigned sp = 0u;
        while (xb_ld(word) < 4u) { __builtin_amdgcn_s_sleep(1); if (++sp > (1u << 22)) break; }
        __builtin_amdgcn_fence(__ATOMIC_ACQUIRE, "agent");
        asm volatile("s_waitcnt vmcnt(0)" ::: "memory");
    }
    __syncthreads();
}

struct Args { const float* in[28]; float* out; unsigned char* ws; int ph_lo, ph_hi; };
__global__ void __launch_bounds__(512, 2) fwd_megakernel(Args args) {
    extern __shared__ __attribute__((aligned(16))) unsigned char lds[];
    cg::grid_group grid = cg::this_grid();
    PG8_LAS unsigned char* ldsl = (PG8_LAS unsigned char*)lds;
    if (threadIdx.x < 16) ((volatile LAS unsigned*)(ldsl + LDS_PHASE))[threadIdx.x] = 0u;
    __syncthreads();
    int team_same = 0;
    XcdBarrier xbar = xcd_barrier_post((unsigned*)(args.ws + WS_BAR), (volatile LAS unsigned*)(ldsl + LDS_PHASE));
    if (threadIdx.x == 0) __hip_atomic_store((unsigned*)(args.ws + WS_TEAMX) + blockIdx.x, xbar.x + 1u, __ATOMIC_RELAXED, __HIP_MEMORY_SCOPE_AGENT);
    if (args.ph_hi > 1000) grid.sync();
    for (int ph = args.ph_lo; ph < args.ph_hi; ++ph) {
        if (ph == NPH - 1 && gridDim.x == 256) continue;
        if (ph == args.ph_lo + 1) xcd_barrier(xbar);
        else if (ph > args.ph_lo + 1) {
            const int sp_ = (ph - 1) % 14, lp_ = (ph - 1) / 14;
            if (ph == args.ph_lo + 3 && gridDim.x == 256) {
                const unsigned* tx = (const unsigned*)(args.ws + WS_TEAMX); const int c0 = blockIdx.x & 63; unsigned same = 1u;
                const unsigned me = xb_ld((unsigned*)tx + blockIdx.x);
#pragma unroll
                for (int k = 0; k < 4; ++k) same &= (xb_ld((unsigned*)tx + c0 + 64 * k) == me) ? 1u : 0u;
                team_same = __builtin_amdgcn_readfirstlane((int)(same & (me != 0u ? 1u : 0u)));
            }
            if (gridDim.x == 256 && (sp_ == 2 || sp_ == 3 || sp_ == 8 || sp_ == 9 || sp_ == 13)) {
                const int c_ = blockIdx.x, pm_ = 8 * (c_ & 7) + ((c_ >> 3) & 7);
                team_sync((unsigned*)(args.ws + WS_TEAM) + (size_t)(ph * 64 + pm_) * 64, threadIdx.x, team_same);
            } else xcd_barrier(xbar);
        }
        int tid = threadIdx.x; asm volatile("" : "+v"(tid));
        int bid = blockIdx.x, G = gridDim.x; asm volatile("" : "+s"(bid), "+s"(G));
        __attribute__((address_space(1))) unsigned char* wsg = (__attribute__((address_space(1))) unsigned char*)args.ws; asm volatile("" : "+s"(wsg)); unsigned char* ws = (unsigned char*)wsg;
        Ctx C;
        { KArgP kb = (KArgP)__builtin_amdgcn_kernarg_segment_ptr(); asm volatile("" : "+s"(kb)); C.kin = kb; }
        C.X = args.out; C.ws = ws;
        C.LB = (float*)(ws + WS_LB); C.AR = (float*)(ws + WS_AR); C.AI = (float*)(ws + WS_AI); C.DEC = (float*)(ws + WS_DEC); C.AGG = (float*)(ws + WS_AGG); C.SLOC = (float*)(ws + WS_SLOC);
        C.BBT = (bf16*)(ws + WS_BBT); C.CM = (bf16*)(ws + WS_CM); C.W = (bf16*)(ws + WS_W); C.HB = (bf16*)(ws + WS_HB); C.PROJ = (bf16*)(ws + WS_PROJ);
        C.R = (bf16*)(ws + WS_R); C.IX = (bf16*)(ws + WS_IX); C.HGS = (bf16*)(ws + WS_HGS); C.GM = (bf16*)(ws + WS_GM);
        const int lane = tid & 63, wave = __builtin_amdgcn_readfirstlane(tid >> 6);
        const int gw = bid * 8 + wave, NGW = G * 8, gtid = bid * 512 + tid;
        float* scr = (float*)(lds + wave * 16384);
        const bool team_ = (G == 256);
        const int prow_ = (8 * (bid & 7) + ((bid >> 3) & 7)) * 256 + (bid >> 6) * 64 + wave * 8;
        if (ph == NPH - 1) { if (team_) final_norm_rows(C.X, C.in(2), prow_, 1, prow_ + 8, lane); else final_norm_rows(C.X, C.in(2), gw, NGW, NTOK, lane); continue; }
        const int l = ph / 14, s = ph % 14;
        int ngemm = 0;
        if (s == 0 || s == 11) {
            const int j = (s == 0) ? 0 : 1;
            if (team_ && s == 0 && l > 0) norm_rows(C.X, nullptr, C.in(1) + (l * 3) * DM, C.HB, prow_, 1, prow_ + 8, lane);
            else norm_rows((l == 0 && s == 0) ? C.in(0) : C.X, nullptr, C.in(1) + (l * 3 + (j ? 2 : 0)) * DM, C.HB, gw, NGW, NTOK, lane);
            convert_ffn(C, l, j, scr, gw, NGW, lane, 0);
        } else if (s == 3) {
            if (team_) norm_rows(C.X, nullptr, C.in(1) + (l * 3 + 1) * DM, C.HB, prow_, 1, prow_ + 8, lane);
            else norm_rows(C.X, nullptr, C.in(1) + (l * 3 + 1) * DM, C.HB, gw, NGW, NTOK, lane);
            if (!team_) { convert_mixer(C, l, scr, gw, NGW, lane, 0); make_tables(C, l, gtid); }
        } else if (s == 5) {
            { unsigned xw[5]; if (bid < 2048) rg1_load(C, bid, tid, xw);
              for (int it = bid; it < 2048; it += G) rg1_item(C, lds, l, it, tid, wave, lane, it == bid || (G & 7) != 0, xw, it + G); }
            for (int it = bid; it < 256; it += G) s5_chunk<false>(C, lds, l, it, tid, wave, lane);
            for (int it = bid; it < 1024; it += G) hg1_item(C, lds, it, tid, wave, lane);
        } else if (s == 6) {
            for (int it = bid; it < 256; it += G) rgc_item(C, l, it, tid);
            for (int idx = gtid; idx < 131072; idx += G * 512) hg2_elem(C, idx);
            for (int it = bid; it < 256; it += G) s5_chunk<true>(C, lds, l, it, tid, wave, lane);
        } else if (s == 7) {
            if (G == 256) { const int nit = (bid < 128) ? 3 : 5, base = (bid < 128) ? bid * 3 : 384 + (bid - 128) * 5;
                for (int k = 0; k < nit; ++k) hg3_item(C, lds, l, base + k, tid, wave, lane); }
            else for (int it = bid; it < 1024; it += G) hg3_item(C, lds, l, it, tid, wave, lane);
            ngemm = 1;
        }
        else ngemm = 1;
        for (int gi = 0; gi < ngemm; ++gi) {
            pg8::Gemm g; int nseg = 1; Epi E; E.mode = 0; E.O = nullptr; E.ldc = 0; E.X = C.X; E.Xsrc = (l == 0 && s == 2) ? C.in(0) : C.X; E.scale = 1.f; E.aux = nullptr; E.ldaux = 0; E.vec = nullptr; E.first = 0; E.ssq = (float*)(ws + WS_SSQ); E.tword = (unsigned*)(ws + WS_TEAM) + (size_t)(28 * 64 + (8 * (bid & 7) + ((bid >> 3) & 7))) * 64; E.same = team_same;
            if (s == 1 || s == 12) { g = pg8::Gemm{C.HB, C.W + W_GU, NTOK, 2 * DFF, DM, DM, 0, 0, 0, 0}; E.mode = 0; E.O = (bf16*)(ws + WS_ACT); E.ldc = DFF; }
            else if (s == 2 || s == 13) { g = pg8::Gemm{(bf16*)(ws + WS_ACT), C.W + W_D, NTOK, DM, DFF, DFF, 0, 0, 0, 0}; E.mode = 1; E.scale = 0.5f;
                if (team_ && l == 1 && s == 13) { E.mode = 6; E.vec = C.in(2); } }
            else if (s == 4) { g = pg8::Gemm{C.HB, (bf16*)(ws + WS_WI0), NTOK, PW, DM, DM, 0, 0, 0, 0}; E.mode = 2; E.O = C.PROJ; E.ldc = PW; E.vec = C.LB; }
            else if (s == 7) { g = pg8::Gemm{C.PROJ + UA_OFF, C.W + W_GLU, NTOK, 512, 512, PW, 0, 0, 0, 0}; E.mode = 3; E.O = C.PROJ + XC_OFF; E.ldc = PW; E.aux = C.PROJ + UA_OFF; E.ldaux = PW; E.vec = C.in(18) + l * 512; }
            else if (s == 8) { g = pg8::Gemm{C.HB, C.W + W_GMW, NTOK, GMW, DM, DM, 0, 0, 0, 0}; E.mode = 4; E.O = C.GM; E.ldc = GMW; }
            else if (s == 9) { g = pg8::Gemm{C.PROJ, C.W + W_BP, NTOK, DM, 512, PW, XC_OFF * 2, Q_OFF * 2, GC_OFF * 2, DM * 512 * 2};
                E.mode = 5; E.O = C.HB; E.ldc = DM; E.aux = C.GM; E.ldaux = GMW; nseg = 3; }
            else { g = pg8::Gemm{C.HB, C.W + W_WO, NTOK, DM, DM, DM, 0, 0, 0, 0}; E.mode = 1; E.scale = 1.f; }
            pg8::StaticOrder S; S.init(g.M, g.N, G, bid, nseg);
            pg8::gemm_phase<Epi, pg8::StaticOrder, true, true>(ldsl, g, S, E, tid);
            __syncthreads();
        }
        if (s == 1 || s == 12 || s == 4) {
            int tid2 = threadIdx.x, bid2 = blockIdx.x, G2 = gridDim.x; asm volatile("" : "+v"(tid2)); asm volatile("" : "+s"(bid2), "+s"(G2));
            if (bid2 >= (G2 >> 1)) { const int wv2 = __builtin_amdgcn_readfirstlane(tid2 >> 6), hw = (bid2 - (G2 >> 1)) * 8 + wv2, HNW = (G2 - (G2 >> 1)) * 8; float* scr2 = (float*)(lds + wv2 * 16384);
                if (s == 4) convert_mixer(C, l, scr2, hw, HNW, tid2 & 63, 1); else convert_ffn(C, l, s == 1 ? 0 : 1, scr2, hw, HNW, tid2 & 63, 1);
                if (s == 1 && G2 == 256) { convert_mixer(C, l, scr2, hw, HNW, tid2 & 63, 0); make_tables(C, l, (bid2 - (G2 >> 1)) * 512 + tid2); } }
        }
    }
}

extern "C" void kernel_launch(void* const* d_in, const int* in_sizes, int n_in, void* d_out, int out_size, void* d_ws, size_t ws_size, hipStream_t stream) {
    static int grid = 0;
    if (grid == 0) {
        if (n_in != 28 || out_size != NTOK * DM || ws_size < WS_END) { fprintf(stderr, "kernel_launch: unexpected shapes (n_in %d out %d ws %zu)\n", n_in, out_size, ws_size); grid = -1; return; }
        int dev = 0, cus = 0, per_cu = 0;
        hipGetDevice(&dev); hipDeviceGetAttribute(&cus, hipDeviceAttributeMultiprocessorCount, dev);
        hipFuncSetAttribute((const void*)fwd_megakernel, hipFuncAttributeMaxDynamicSharedMemorySize, LDS_BYTES);
        hipOccupancyMaxActiveBlocksPerMultiprocessor(&per_cu, (const void*)fwd_megakernel, 512, LDS_BYTES);
        if (per_cu < 1 || cus < 1) { fprintf(stderr, "kernel_launch: occupancy query says %d blocks per CU (%d CUs)\n", per_cu, cus); grid = -1; return; }
        grid = cus;
    }
    if (grid < 0) return;
    if (hipMemsetAsync((char*)d_ws + WS_TEAM, 0, CTL_BYTES, stream) != hipSuccess) { fprintf(stderr, "kernel_launch: hipMemsetAsync of the control words failed\n"); return; }
    Args a{};
    for (int i = 0; i < 28; ++i) a.in[i] = (const float*)d_in[i];
    a.out = (float*)d_out; a.ws = (unsigned char*)d_ws; a.ph_lo = 0; a.ph_hi = NPH;
    void* kargs[] = {&a};
    hipError_t e = hipLaunchCooperativeKernel((const void*)fwd_megakernel, dim3(grid), dim3(512), kargs, LDS_BYTES, stream);
    if (e != hipSuccess) fprintf(stderr, "cooperative launch failed: %s (grid %d)\n", hipGetErrorString(e), grid);
}
```

```cpp
#include <hip/hip_runtime.h>
#include <hip/hip_cooperative_groups.h>
#include <cstdio>
#include <cstdint>
namespace cg = cooperative_groups;
namespace pg8 {
#define PG8_LAS __attribute__((address_space(3)))
typedef unsigned short bf16_t;
typedef short bf16x8 __attribute__((ext_vector_type(8)));
typedef float f32x4 __attribute__((ext_vector_type(4)));
typedef unsigned u32x4 __attribute__((ext_vector_type(4)));
constexpr int BM = 256, BK = 64, HALF = 128, HTB = HALF * BK * 2  , STAGE_BYTES = 8 * HTB, NXCD = 8, WGM = 8;

__host__ __device__ __forceinline__ int lds_byte(int r, int c) { const int st = (r >> 4) * 2 + (c >> 5), rr = r & 15, cc = c & 31, ob = rr * 64 + cc * 2; return st * 1024 + (ob ^ (((ob >> 9) & 1) << 5)); }
__host__ __device__ __forceinline__ void stage_rc(int b, int& R, int& C) { const int st = b / 1024, sb = b % 1024, swz = sb ^ (((sb >> 9) & 1) << 5); R = (st >> 1) * 16 + swz / 64; C = (st & 1) * 32 + (swz % 64) / 2; }
__host__ __device__ __forceinline__ int perm32(int rho) { const int n = rho >> 4, i = rho & 15; return 8 * (i >> 2) + 4 * n + (i & 3); }

struct Unit { int pm, pn, sg; };
struct Gemm { const bf16_t* A; const bf16_t* Bt; int M, N, K, lda; int so0, so1, so2, bseg; };

struct StaticOrder {
    int nM, nN, nwg, G, c, nseg;
    __host__ __device__ void init(int M, int N, int G_, int c_, int nseg_ = 1) { nM = M / BM; nN = N / BM; nwg = nM * nN; G = G_; c = c_; nseg = nseg_; }
    __host__ __device__ bool next(int i, Unit& u) const {
        const int ib = i / nseg; u.sg = i - ib * nseg;
        const long L = (long)ib * G + c; if (L >= nwg) return false;
        int wgid = (int)L; { const int q = nwg / NXCD, r = nwg % NXCD, xcd = wgid % NXCD, off = wgid / NXCD; wgid = (xcd < r ? xcd * (q + 1) : r * (q + 1) + (xcd - r) * q) + off; }
        const int nig = WGM * nN, gid = wgid / nig, fm = gid * WGM, gsz = (nM - fm) < WGM ? (nM - fm) : WGM;
        u.pm = fm + ((wgid % nig) % gsz); u.pn = (wgid % nig) / gsz; return true;
    }
    __device__ __forceinline__ void a_ready(const Unit&) const {}
    __device__ __forceinline__ void done(const Unit&) const {}
};


template <class Epi, class Sched, bool ALIGN_EPI = false, bool SP2 = false>
__device__ __forceinline__ void gemm_phase(PG8_LAS unsigned char* lds, const Gemm g, const Sched& S, const Epi& E, const int tid) {
    const int wid = __builtin_amdgcn_readfirstlane(tid >> 6), lane = tid & 63, wr = wid >> 2, wc = wid & 3, fr = lane & 15, fq = lane >> 4;
    const int K = g.K, nt = K / BK;
    unsigned voffA[2], voffB[2];
#pragma unroll
    for (int i = 0; i < 2; ++i) { int R, C; stage_rc(tid * 16 + i * 8192, R, C); const int Rb = Epi::PERM ? ((R & ~31) + perm32(R & 31)) : R;
        voffA[i] = (unsigned)(R * g.lda + C) * 2u; voffB[i] = (unsigned)(Rb * K + C) * 2u; }
    const size_t kstep = (size_t)(BK * 2);
    const size_t hstepA = (size_t)HALF * g.lda * 2, hstepB = (size_t)HALF * K * 2;
    const size_t tstepA = 2 * hstepA, tstepB = 2 * hstepB;
    const unsigned ldsw = (unsigned)wid * 1024u;
    const int aoff = lds_byte(wr * 64 + fr, fq * 8), boff = lds_byte(wc * 32 + fr, fq * 8);
#define PG8_SA(b, h) (((b) * 2 + (h)) * HTB)
#define PG8_SB(b, h) ((4 + (b) * 2 + (h)) * HTB)
#define PG8_STAGE(bufoff, gbase, voff) do { _Pragma("unroll") for (int _i = 0; _i < 2; ++_i) \
        __builtin_amdgcn_global_load_lds((const unsigned*)((const char*)(gbase) + (voff)[_i]), (PG8_LAS unsigned*)(lds + (bufoff) + ldsw + _i * 8192), 16, 0, 0); } while (0)
#define PG8_LDA(dst, b, h) do { _Pragma("unroll") for (int m = 0; m < 4; ++m) _Pragma("unroll") for (int k = 0; k < 2; ++k) dst[m][k] = *(const PG8_LAS bf16x8*)(lds + PG8_SA(b, h) + aoff + m * 2048 + k * 1024); } while (0)
#define PG8_LDB(dst, b, h) do { _Pragma("unroll") for (int n = 0; n < 2; ++n) _Pragma("unroll") for (int k = 0; k < 2; ++k) dst[n][k] = *(const PG8_LAS bf16x8*)(lds + PG8_SB(b, h) + boff + n * 2048 + k * 1024); } while (0)
#define PG8_MMA(ai, bj, At, Bt) do { __builtin_amdgcn_s_setprio(1); _Pragma("unroll") for (int m = 0; m < 4; ++m) _Pragma("unroll") for (int n = 0; n < 2; ++n) _Pragma("unroll") for (int k = 0; k < 2; ++k) \
        acc[ai][bj][m][n] = __builtin_amdgcn_mfma_f32_16x16x32_bf16(Bt[n][k], At[m][k], acc[ai][bj][m][n], 0, 0, 0); __builtin_amdgcn_s_setprio(0); } while (0)
#define PG8_WAIT_V(n) asm volatile("s_waitcnt vmcnt(" #n ")" ::: "memory")
#define PG8_WAIT_L(n) asm volatile("s_waitcnt lgkmcnt(" #n ")" ::: "memory")
#define PG8_BAR __builtin_amdgcn_s_barrier()
#define PG8_SCHED __builtin_amdgcn_sched_barrier(0)
    Unit cur, nxt; int ui = 0;
    if (!S.next(0, cur)) return;
    f32x4 acc[2][2][4][2];
#pragma unroll
    for (int a = 0; a < 2; ++a)
#pragma unroll
        for (int b = 0; b < 2; ++b)
#pragma unroll
            for (int m = 0; m < 4; ++m)
#pragma unroll
                for (int n = 0; n < 2; ++n) acc[a][b][m][n] = (f32x4){0.f, 0.f, 0.f, 0.f};
    bf16x8 At[4][2], B0[2][2], B1[2][2];
#define PG8_SO(u) ((size_t)((u).sg == 0 ? g.so0 : ((u).sg == 1 ? g.so1 : g.so2)))
    const char* cA = (const char*)g.A + (size_t)cur.pm * tstepA + PG8_SO(cur); const char* cB = (const char*)g.Bt + (size_t)cur.pn * tstepB + (size_t)cur.sg * g.bseg;
    S.a_ready(cur);
    if constexpr (SP2) {
        PG8_STAGE(PG8_SB(0, 0), cB, voffB); PG8_STAGE(PG8_SB(0, 1), cB + hstepB, voffB); PG8_STAGE(PG8_SA(0, 0), cA, voffA); PG8_STAGE(PG8_SA(0, 1), cA + hstepA, voffA);
        if (wr == 1) PG8_BAR;
        PG8_WAIT_V(2); PG8_BAR;
        PG8_STAGE(PG8_SB(1, 0), cB + kstep, voffB); PG8_STAGE(PG8_SA(1, 0), cA + kstep, voffA); PG8_STAGE(PG8_SB(1, 1), cB + hstepB + kstep, voffB);
        PG8_WAIT_V(6); PG8_BAR;
    } else {
        PG8_STAGE(PG8_SB(0, 0), cB, voffB); PG8_STAGE(PG8_SA(0, 0), cA, voffA); PG8_STAGE(PG8_SB(0, 1), cB + hstepB, voffB); PG8_STAGE(PG8_SA(0, 1), cA + hstepA, voffA);
        if (wr == 1) PG8_BAR;
        PG8_WAIT_V(4); PG8_BAR;
        PG8_STAGE(PG8_SB(1, 0), cB + kstep, voffB); PG8_STAGE(PG8_SA(1, 0), cA + kstep, voffA); PG8_STAGE(PG8_SB(1, 1), cB + hstepB + kstep, voffB);
        PG8_WAIT_V(6); PG8_BAR;
    }
    for (;;) {
        const bool has_next = S.next(ui + 1, nxt);
        const char* nA = has_next ? (const char*)g.A + (size_t)nxt.pm * tstepA + PG8_SO(nxt) : cA; const char* nB = has_next ? (const char*)g.Bt + (size_t)nxt.pn * tstepB + (size_t)nxt.sg * g.bseg : cB;
        for (int t = 0; t < nt; t += 2) {
            const bool last = (t == nt - 2);
            const char* a1 = cA + (size_t)(t + 1) * kstep;
            const char* a2 = last ? nA : cA + (size_t)(t + 2) * kstep; const char* b2 = last ? nB : cB + (size_t)(t + 2) * kstep;
            const char* a3 = a2 + kstep; const char* b3 = b2 + kstep;
            if (last && has_next) S.a_ready(nxt);
            if constexpr (SP2) {
            PG8_LDB(B0, 0, 0); PG8_LDB(B1, 0, 1); PG8_SCHED; PG8_LDA(At, 0, 0); PG8_STAGE(PG8_SA(1, 1), a1 + hstepA, voffA);
            PG8_WAIT_V(8); PG8_WAIT_L(0); PG8_BAR; PG8_MMA(0, 0, At, B0); PG8_MMA(0, 1, At, B1); PG8_BAR; PG8_SCHED;
            PG8_LDA(At, 0, 1); PG8_STAGE(PG8_SB(0, 0), b2, voffB); PG8_STAGE(PG8_SB(0, 1), b2 + hstepB, voffB); PG8_STAGE(PG8_SA(0, 0), a2, voffA);
            PG8_WAIT_V(8); PG8_WAIT_L(0); PG8_BAR; PG8_MMA(1, 0, At, B0); PG8_MMA(1, 1, At, B1); PG8_BAR; PG8_SCHED;
            PG8_LDB(B0, 1, 0); PG8_LDB(B1, 1, 1); PG8_SCHED; PG8_LDA(At, 1, 0); PG8_STAGE(PG8_SA(0, 1), a2 + hstepA, voffA);
            PG8_WAIT_V(8); PG8_WAIT_L(0); PG8_BAR; PG8_MMA(0, 0, At, B0); PG8_MMA(0, 1, At, B1); PG8_BAR; PG8_SCHED;
            PG8_LDA(At, 1, 1); PG8_STAGE(PG8_SB(1, 0), b3, voffB); PG8_STAGE(PG8_SB(1, 1), b3 + hstepB, voffB); PG8_STAGE(PG8_SA(1, 0), a3, voffA);
            PG8_WAIT_V(8); PG8_WAIT_L(0); PG8_BAR; PG8_MMA(1, 0, At, B0); PG8_MMA(1, 1, At, B1); PG8_BAR; PG8_SCHED;
            } else {
            PG8_LDB(B0, 0, 0); PG8_SCHED; PG8_LDA(At, 0, 0); PG8_STAGE(PG8_SA(1, 1), a1 + hstepA, voffA);
            PG8_WAIT_L(8); PG8_BAR; PG8_WAIT_L(0); PG8_MMA(0, 0, At, B0); PG8_BAR; PG8_SCHED;
            PG8_LDB(B1, 0, 1); PG8_STAGE(PG8_SB(0, 0), b2, voffB);
            PG8_BAR; PG8_WAIT_L(0); PG8_MMA(0, 1, At, B1); PG8_BAR;
            PG8_LDA(At, 0, 1); PG8_STAGE(PG8_SA(0, 0), a2, voffA);
            PG8_BAR; PG8_WAIT_L(0); PG8_MMA(1, 0, At, B0); PG8_BAR; PG8_SCHED;
            PG8_STAGE(PG8_SB(0, 1), b2 + hstepB, voffB);
            PG8_WAIT_V(6); PG8_BAR; PG8_MMA(1, 1, At, B1); PG8_BAR;
            PG8_LDB(B0, 1, 0); PG8_SCHED; PG8_LDA(At, 1, 0); PG8_STAGE(PG8_SA(0, 1), a2 + hstepA, voffA);
            PG8_WAIT_L(8); PG8_BAR; PG8_WAIT_L(0); PG8_MMA(0, 0, At, B0); PG8_BAR; PG8_SCHED;
            PG8_LDB(B1, 1, 1); PG8_STAGE(PG8_SB(1, 0), b3, voffB);
            PG8_BAR; PG8_WAIT_L(0); PG8_MMA(0, 1, At, B1); PG8_BAR;
            PG8_LDA(At, 1, 1); PG8_STAGE(PG8_SA(1, 0), a3, voffA);
            PG8_BAR; PG8_WAIT_L(0); PG8_MMA(1, 0, At, B0); PG8_BAR; PG8_SCHED;
            PG8_STAGE(PG8_SB(1, 1), b3 + hstepB, voffB);
            PG8_WAIT_V(6); PG8_BAR; PG8_MMA(1, 1, At, B1); PG8_BAR;
            }
        }
        if constexpr (ALIGN_EPI) { if (wr == 0) PG8_BAR; }
        if (!E.drain()) { E(acc, cur, wr, wc, fr, fq); S.done(cur); }
        if (!has_next) break;
#pragma unroll
        for (int a = 0; a < 2; ++a)
#pragma unroll
            for (int b = 0; b < 2; ++b)
#pragma unroll
                for (int m = 0; m < 4; ++m)
#pragma unroll
                    for (int n = 0; n < 2; ++n) acc[a][b][m][n] = (f32x4){0.f, 0.f, 0.f, 0.f};
        cur = nxt; cA = nA; cB = nB; ++ui;
        if constexpr (ALIGN_EPI) { if (wr == 1) PG8_BAR; }
    }
    PG8_WAIT_V(0);
    if constexpr (!ALIGN_EPI) { if (wr == 0) PG8_BAR; }
    PG8_BAR;
    if (E.drain()) { E.fused(acc, cur, wr, wc, fr, fq, lds, wid, lane); S.done(cur); }
#undef PG8_SO
#undef PG8_SA
#undef PG8_SB
#undef PG8_STAGE
#undef PG8_LDA
#undef PG8_LDB
#undef PG8_MMA
#undef PG8_WAIT_V
#undef PG8_WAIT_L
#undef PG8_BAR
#undef PG8_SCHED
}
}


typedef unsigned short bf16;
typedef pg8::bf16x8 bf16x8;
typedef pg8::f32x4 f32x4;
typedef pg8::u32x4 u32x4;
typedef unsigned u32x2 __attribute__((ext_vector_type(2)));
typedef float f32x2 __attribute__((ext_vector_type(2)));
constexpr int NTOK = 16384, DM = 1024, DFF = 2816;
constexpr int PW = 3584, GMW = 3072;
constexpr int UA_OFF = 0, Q_OFF = 512, F_OFF = 1024, V_OFF = 1536, G_OFF = 2048, XC_OFF = 2560, GC_OFF = 3072;
constexpr size_t MiB = 1u << 20;
constexpr size_t WS_LB = 0, WS_AR = 8192, WS_AI = 16384, WS_BBT = 65536, WS_CM = 512 * 1024, WS_DEC = 1 * MiB, WS_AGG = 2 * MiB, WS_SLOC = 4 * MiB,
                 WS_W = 8 * MiB, WS_HB = 28 * MiB, WS_PROJ = 60 * MiB, WS_R = 172 * MiB, WS_IX = 188 * MiB, WS_HGS = 204 * MiB, WS_GM = 172 * MiB, WS_ACT = 172 * MiB, WS_WI0 = 260 * MiB, WS_TEAM = 268 * MiB, WS_TEAMX = 268 * MiB + 950272, WS_SSQ = 269 * MiB, WS_END = 269 * MiB + 262144;
constexpr size_t W_GU = 0, W_D = (size_t)7602176;
constexpr size_t W_GMW = 0, W_BP = (size_t)3072 * 1024, W_WO = W_BP + (size_t)3 * 1024 * 512, W_GLU = W_WO + (size_t)1024 * 1024;
static_assert((W_GLU + 512 * 512) <= W_D && (W_D + (size_t)1024 * 2816) * 2 <= 20 * MiB && (size_t)5632 * 1024 <= W_D, "W region");
constexpr int LDS_PHASE = 143360;
constexpr int LDS_BYTES = LDS_PHASE + 64;
constexpr size_t WS_BAR = 268 * MiB + 950272 + 1024;
constexpr size_t CTL_BYTES = 950272 + 1024 + 3456 * 4;
constexpr int NPH = 29;

typedef __bf16 bf16x2_t __attribute__((ext_vector_type(2)));
__device__ __forceinline__ unsigned pk2(float lo, float hi) { f32x2 v = {lo, hi}; bf16x2_t b = __builtin_convertvector(v, bf16x2_t); return __builtin_bit_cast(unsigned, b); }
__device__ __forceinline__ unsigned f2bf(float f) { return pk2(f, 0.f) & 0xffffu; }
__device__ __forceinline__ float bf2f(unsigned h) { return __builtin_bit_cast(float, h << 16); }
__device__ __forceinline__ float rcp_(float x) { return __builtin_amdgcn_rcpf(x); }
__device__ __forceinline__ float sigm(float x) { return rcp_(1.f + __expf(-x)); }
__device__ __forceinline__ float silu_(float x) { return x * sigm(x); }
__device__ __forceinline__ float gelu_(float x) { return x * sigm(1.5957691216057308f * (x + 0.044715f * x * x * x)); }
__device__ __forceinline__ void load8(const bf16* p, float (&v)[8]) {
    const u32x4 w = *(const u32x4*)p;
#pragma unroll
    for (int i = 0; i < 4; ++i) { v[2 * i] = __builtin_bit_cast(float, w[i] << 16); v[2 * i + 1] = __builtin_bit_cast(float, w[i] & 0xffff0000u); }
}
__device__ __forceinline__ void store8(bf16* p, const float (&v)[8]) {
    u32x4 w; w.x = pk2(v[0], v[1]); w.y = pk2(v[2], v[3]); w.z = pk2(v[4], v[5]); w.w = pk2(v[6], v[7]); *(u32x4*)p = w;
}
__device__ __forceinline__ float wave_sum(float v) {
#pragma unroll
    for (int o = 1; o < 64; o <<= 1) v += __shfl_xor(v, o);
    return v;
}
#define LBAR() do { asm volatile("s_waitcnt lgkmcnt(0)" ::: "memory"); __builtin_amdgcn_s_barrier(); asm volatile("" ::: "memory"); } while (0)
#define MFMA16(a, b, c) __builtin_amdgcn_mfma_f32_16x16x32_bf16((a), (b), (c), 0, 0, 0)

__device__ __forceinline__ void team_sync(unsigned* word, int tid, int same_xcd);
struct Epi {
    static constexpr bool PERM = true, AFTER_DRAIN = false;
    int mode; bf16* O; int ldc; float* X; const float* Xsrc; float scale; const bf16* aux; int ldaux; const float* vec; int first; float* ssq; unsigned* tword; int same;
    __device__ __forceinline__ bool drain() const { return mode >= 6; }
    __device__ __forceinline__ void operator()(const f32x4 (&acc)[2][2][4][2], const pg8::Unit& u, int wr, int wc, int fr, int fq) const {
        const int row0 = u.pm * 256 + wr * 64 + fr, cl = wc * 32 + 8 * fq;
        if (mode == 0) {
#pragma unroll
            for (int ai = 0; ai < 2; ++ai)
#pragma unroll
                for (int m = 0; m < 4; ++m) { const int row = row0 + ai * 128 + m * 16; float v[8];
#pragma unroll
                    for (int n = 0; n < 2; ++n)
#pragma unroll
                        for (int j = 0; j < 4; ++j) v[n * 4 + j] = silu_(acc[ai][0][m][n][j]) * acc[ai][1][m][n][j];
                    store8(O + (size_t)row * ldc + u.pn * 128 + cl, v); }
        } else if (mode == 1) {
#pragma unroll
            for (int ai = 0; ai < 2; ++ai)
#pragma unroll
                for (int m = 0; m < 4; ++m) { const int row = row0 + ai * 128 + m * 16;
#pragma unroll
                    for (int bj = 0; bj < 2; ++bj) { const size_t off = (size_t)row * DM + u.pn * 256 + bj * 128 + cl; float* p = X + off; const float* ps = Xsrc + off;
#pragma unroll
                        for (int n = 0; n < 2; ++n) { f32x4 o = *(const f32x4*)(ps + 4 * n); o = o + acc[ai][bj][m][n] * scale; *(f32x4*)(p + 4 * n) = o; } } }
        } else if (mode == 2) {
            const int seg = u.pn >> 1;
#define PROJ_EPI(EXPR) \
            _Pragma("unroll") for (int bj = 0; bj < 2; ++bj) { const int c0 = u.pn * 256 + bj * 128 + cl; \
                _Pragma("unroll") for (int ai = 0; ai < 2; ++ai) _Pragma("unroll") for (int m = 0; m < 4; ++m) { const int row = row0 + ai * 128 + m * 16; float v[8]; \
                    _Pragma("unroll") for (int n = 0; n < 2; ++n) _Pragma("unroll") for (int j = 0; j < 4; ++j) { const float a = acc[ai][bj][m][n][j]; const int i8 = n * 4 + j; (void)i8; v[n * 4 + j] = (EXPR); } \
                    store8(O + (size_t)row * PW + c0, v); } }
            if (seg == 1 || seg == 4) { PROJ_EPI(silu_(a)) }
            else if (seg == 6) { PROJ_EPI(gelu_(a)) }
            else if (seg == 2) {
#pragma unroll
                for (int bj = 0; bj < 2; ++bj) { const int c0 = u.pn * 256 + bj * 128 + cl; float lb[8];
#pragma unroll
                    for (int i = 0; i < 8; ++i) lb[i] = vec[c0 - F_OFF + i];
#pragma unroll
                    for (int ai = 0; ai < 2; ++ai)
#pragma unroll
                        for (int m = 0; m < 4; ++m) { const int row = row0 + ai * 128 + m * 16; float v[8];
#pragma unroll
                            for (int i = 0; i < 8; ++i) { const float a = acc[ai][bj][m][i >> 2][i & 3]; v[i] = __logf(lb[i] + (1.f - lb[i]) * sigm(a)); }
                            store8(O + (size_t)row * PW + c0, v); } }
            } else { PROJ_EPI(a) }
#undef PROJ_EPI
        } else if (mode == 3) {
#pragma unroll
            for (int bj = 0; bj < 2; ++bj) { const int c0 = u.pn * 256 + bj * 128 + cl; float bb[8];
#pragma unroll
                for (int i = 0; i < 8; ++i) bb[i] = vec[c0 + i];
#pragma unroll
                for (int ai = 0; ai < 2; ++ai)
#pragma unroll
                    for (int m = 0; m < 4; ++m) { const int row = row0 + ai * 128 + m * 16; float z[8], v[8]; load8(aux + (size_t)row * ldaux + c0, z);
#pragma unroll
                        for (int n = 0; n < 2; ++n)
#pragma unroll
                            for (int j = 0; j < 4; ++j) v[n * 4 + j] = z[n * 4 + j] * sigm(acc[ai][bj][m][n][j] + bb[n * 4 + j]);
                        store8(O + (size_t)row * ldc + c0, v); } }
        } else if (mode == 4) {
#pragma unroll
            for (int bj = 0; bj < 2; ++bj) { const int c0 = u.pn * 256 + bj * 128 + cl;
#pragma unroll
                for (int ai = 0; ai < 2; ++ai)
#pragma unroll
                    for (int m = 0; m < 4; ++m) { const int row = row0 + ai * 128 + m * 16; float v[8];
#pragma unroll
                        for (int n = 0; n < 2; ++n)
#pragma unroll
                            for (int j = 0; j < 4; ++j) v[n * 4 + j] = sigm(acc[ai][bj][m][n][j]);
                        store8(O + (size_t)row * ldc + c0, v); } }
        } else {
            const bf16* gate = aux + (size_t)u.sg * DM; const int first_ = (u.sg == 0);
#pragma unroll
            for (int bj = 0; bj < 2; ++bj) { const int c0 = u.pn * 256 + bj * 128 + cl;
#pragma unroll
                for (int ai = 0; ai < 2; ++ai)
#pragma unroll
                    for (int m = 0; m < 4; ++m) { const int row = row0 + ai * 128 + m * 16; float gt[8], v[8]; load8(gate + (size_t)row * ldaux + c0, gt);
                        if (first_) {
#pragma unroll
                            for (int i = 0; i < 8; ++i) v[i] = 0.f; } else load8(O + (size_t)row * ldc + c0, v);
#pragma unroll
                        for (int n = 0; n < 2; ++n)
#pragma unroll
                            for (int j = 0; j < 4; ++j) v[n * 4 + j] += gt[n * 4 + j] * acc[ai][bj][m][n][j];
                        store8(O + (size_t)row * ldc + c0, v); } }
        }
    }
    __device__ __forceinline__ void fused(f32x4 (&acc)[2][2][4][2], const pg8::Unit& u, int wr, int wc, int fr, int fq, PG8_LAS unsigned char* lds, int wid, int lane) const {
        PG8_LAS float* P = (PG8_LAS float*)lds;
        const int row0 = u.pm * 256 + wr * 64 + fr, cl = wc * 32 + 8 * fq;
#pragma unroll
        for (int ai = 0; ai < 2; ++ai)
#pragma unroll
            for (int m = 0; m < 4; ++m) { const int row = row0 + ai * 128 + m * 16; float ss = 0.f;
#pragma unroll
                for (int bj = 0; bj < 2; ++bj) { const float* ps = Xsrc + (size_t)row * DM + u.pn * 256 + bj * 128 + cl;
#pragma unroll
                    for (int n = 0; n < 2; ++n) { f32x4 o = *(const f32x4*)(ps + 4 * n); o = o + acc[ai][bj][m][n] * scale; acc[ai][bj][m][n] = o; ss += (o.x * o.x + o.y * o.y) + (o.z * o.z + o.w * o.w); } }
                ss += __shfl_xor(ss, 16); ss += __shfl_xor(ss, 32);
                if (fq == 0) P[(ai * 128 + wr * 64 + m * 16 + fr) * 4 + wc] = ss;
                if (m & 1) asm volatile("" ::: "memory"); }
        __syncthreads();
        const int t = wid * 64 + lane;
        if (t < 256) { const float a = P[t * 4 + 0], b = P[t * 4 + 1], c = P[t * 4 + 2], d = P[t * 4 + 3]; ssq[(size_t)(u.pm * 256 + t) * 4 + u.pn] = (a + b) + (c + d); }
        team_sync(tword, t, same);
#pragma unroll
        for (int ai = 0; ai < 2; ++ai)
#pragma unroll
            for (int m = 0; m < 4; ++m) { const int row = row0 + ai * 128 + m * 16; const f32x4 q4 = *(const f32x4*)(ssq + (size_t)row * 4);
                const float rstd = __builtin_amdgcn_rsqf(((q4.x + q4.y) + (q4.z + q4.w)) * (1.f / DM) + 1e-6f);
#pragma unroll
                for (int bj = 0; bj < 2; ++bj) { const int col = u.pn * 256 + bj * 128 + cl; float* po = X + (size_t)row * DM + col;
                    if (mode == 6) {
#pragma unroll
                        for (int n = 0; n < 2; ++n) { const f32x4 wv = *(const f32x4*)(vec + col + 4 * n); *(f32x4*)(po + 4 * n) = acc[ai][bj][m][n] * rstd * wv; } }
                    else {
                        const f32x4 w0 = *(const f32x4*)(vec + col), w1 = *(const f32x4*)(vec + col + 4); const f32x4 x0 = acc[ai][bj][m][0], x1 = acc[ai][bj][m][1];
                        *(f32x4*)po = x0; *(f32x4*)(po + 4) = x1;
                        const f32x4 y0 = x0 * rstd * w0, y1 = x1 * rstd * w1; const float v[8] = {y0.x, y0.y, y0.z, y0.w, y1.x, y1.y, y1.z, y1.w};
                        store8(O + (size_t)row * DM + col, v); } } }
    }
};

typedef const __attribute__((address_space(1))) float* inptr_t;
typedef const __attribute__((address_space(4))) inptr_t* KArgP;
struct Ctx {
    KArgP kin; float* X; unsigned char* ws;
    __device__ __forceinline__ const float* in(int k) const { return (const float*)kin[k]; }
    float *LB, *AR, *AI, *DEC, *AGG, *SLOC; bf16 *BBT, *CM, *W, *HB, *PROJ, *R, *IX, *HGS, *GM;
};

__device__ __forceinline__ void norm_rows(const float* src, float* cpy, const float* w, bf16* dst, int gw, int NGW, int mend, int lane) {
    f32x4 wv[4];
#pragma unroll
    for (int j = 0; j < 4; ++j) wv[j] = ((const f32x4*)w)[lane + 64 * j];
    for (int m0 = gw; m0 < mend; m0 += 2 * NGW) {
        const int m1 = (m0 + NGW < mend) ? m0 + NGW : m0;
        const f32x4* xr0 = (const f32x4*)(src + (size_t)m0 * DM) + lane; const f32x4* xr1 = (const f32x4*)(src + (size_t)m1 * DM) + lane; f32x4 v[2][4]; float s0 = 0.f, s1 = 0.f;
#pragma unroll
        for (int j = 0; j < 4; ++j) { v[0][j] = xr0[64 * j]; v[1][j] = xr1[64 * j]; }
#pragma unroll
        for (int j = 0; j < 4; ++j) { s0 += (v[0][j].x * v[0][j].x + v[0][j].y * v[0][j].y) + (v[0][j].z * v[0][j].z + v[0][j].w * v[0][j].w);
                                      s1 += (v[1][j].x * v[1][j].x + v[1][j].y * v[1][j].y) + (v[1][j].z * v[1][j].z + v[1][j].w * v[1][j].w); }
        s0 = wave_sum(s0); s1 = wave_sum(s1);
#pragma unroll
        for (int rr = 0; rr < 2; ++rr) { const int m = rr ? m1 : m0; if (rr && m1 == m0) break; const float rstd = __builtin_amdgcn_rsqf((rr ? s1 : s0) * (1.f / DM) + 1e-6f);
            if (cpy) { f32x4* c = (f32x4*)(cpy + (size_t)m * DM) + lane;
#pragma unroll
                for (int j = 0; j < 4; ++j) c[64 * j] = v[rr][j]; }
            u32x2* o = (u32x2*)(dst + (size_t)m * DM) + lane;
#pragma unroll
            for (int j = 0; j < 4; ++j) { u32x2 pp; pp.x = pk2(v[rr][j].x * rstd * wv[j].x, v[rr][j].y * rstd * wv[j].y); pp.y = pk2(v[rr][j].z * rstd * wv[j].z, v[rr][j].w * rstd * wv[j].w); o[64 * j] = pp; } }
    }
}
__device__ __forceinline__ void final_norm_rows(float* X, const float* w, int gw, int NGW, int mend, int lane) {
    f32x4 wv[4];
#pragma unroll
    for (int j = 0; j < 4; ++j) wv[j] = ((const f32x4*)w)[lane + 64 * j];
    for (int m = gw; m < mend; m += NGW) {
        f32x4* xr = (f32x4*)(X + (size_t)m * DM) + lane; f32x4 v[4]; float s = 0.f;
#pragma unroll
        for (int j = 0; j < 4; ++j) { v[j] = xr[64 * j]; s += (v[j].x * v[j].x + v[j].y * v[j].y) + (v[j].z * v[j].z + v[j].w * v[j].w); }
        s = wave_sum(s); const float rstd = __builtin_amdgcn_rsqf(s * (1.f / DM) + 1e-6f);
#pragma unroll
        for (int j = 0; j < 4; ++j) xr[64 * j] = v[j] * rstd * wv[j];
    }
}
__device__ __forceinline__ void transpose_item(const float* W, int N, bf16* WT, int ldt, int k0, int n0, int dst_row0, float* scr, int lane) {
    float rg_[32];
#pragma unroll
    for (int i = 0; i < 32; ++i) rg_[i] = W[(size_t)(k0 + 2 * i + (lane >> 5)) * N + n0 + (lane & 31)];
#pragma unroll
    for (int i = 0; i < 32; ++i) scr[(2 * i + (lane >> 5)) * 33 + (lane & 31)] = rg_[i];
    asm volatile("s_waitcnt lgkmcnt(0)" ::: "memory");
    const int c = lane & 7;
#pragma unroll
    for (int j = 0; j < 4; ++j) { const int n = (lane >> 3) + 8 * j; const float* s = scr + (8 * c) * 33 + n;
        u32x4 o; o.x = pk2(s[0 * 33], s[1 * 33]); o.y = pk2(s[2 * 33], s[3 * 33]); o.z = pk2(s[4 * 33], s[5 * 33]); o.w = pk2(s[6 * 33], s[7 * 33]);
        *(u32x4*)(WT + (size_t)(dst_row0 + n) * ldt + k0 + 8 * c) = o; }
    asm volatile("s_waitcnt lgkmcnt(0)" ::: "memory");
}
__device__ __forceinline__ void convert_ffn(const Ctx& C, int l, int j, float* scr, int gw, int NGW, int lane, int part) {
    const float* Wg = C.in(3) + (size_t)(l * 2 + j) * DM * DFF; const float* Wu = C.in(4) + (size_t)(l * 2 + j) * DM * DFF; const float* Wd = C.in(5) + (size_t)(l * 2 + j) * DFF * DM;
    for (int it = (part ? 2816 : 0) + gw; it < (part ? 3 * 1408 : 2816); it += NGW) {
        if (it < 2816) { const int up = it >= 1408, r = it - up * 1408, kb = r / 88, nb = r % 88, n0 = 32 * nb;
            transpose_item(up ? Wu : Wg, DFF, C.W + W_GU, DM, 64 * kb, n0, (n0 >> 7) * 256 + (n0 & 127) + up * 128, scr, lane); }
        else { const int r = it - 2816, kb = r >> 5, nb = r & 31; transpose_item(Wd, DM, C.W + W_D, DFF, 64 * kb, 32 * nb, 32 * nb, scr, lane); }
    }
}
__device__ __forceinline__ void convert_mixer(const Ctx& C, int l, float* scr, int gw, int NGW, int lane, int part) {
    if (part == 0) {
        for (int r = gw; r < 1792; r += NGW) { const int kb = r / 112, nb = r % 112; transpose_item(C.in(6) + (size_t)l * DM * 6656, 6656, (bf16*)(C.ws + WS_WI0), DM, 64 * kb, 32 * nb, 32 * nb, scr, lane); }
        return;
    }
    for (int it = gw; it < 1536 + 768 + 512 + 128; it += NGW) {
        int r = it;
        if (r < 1536) { const int kb = r / 96, nb = 112 + r % 96; transpose_item(C.in(6) + (size_t)l * DM * 6656, 6656, C.W + W_GMW, DM, 64 * kb, 32 * nb, 32 * nb - PW, scr, lane); continue; } r -= 1536;
        if (r < 768) { const int n = r >> 8, q = r & 255, kb = q >> 5, nb = q & 31; transpose_item(C.in(7) + (size_t)(l * 3 + n) * 512 * DM, DM, C.W + W_BP + (size_t)n * DM * 512, 512, 64 * kb, 32 * nb, 32 * nb, scr, lane); continue; } r -= 768;
        if (r < 512) { const int kb = r >> 5, nb = r & 31; transpose_item(C.in(8) + (size_t)l * DM * DM, DM, C.W + W_WO, DM, 64 * kb, 32 * nb, 32 * nb, scr, lane); continue; } r -= 512;
        { const int kb = r >> 4, nb = r & 15; transpose_item(C.in(17) + (size_t)l * 512 * 512, 512, C.W + W_GLU, 512, 64 * kb, 32 * nb, 32 * nb, scr, lane); }
    }
}
__device__ __forceinline__ void make_tables(const Ctx& C, int l, int gtid) {
    if (gtid < 2048) {
        const int g = gtid >> 6, p = gtid & 63, gp = (l * 32 + g) * 64 + p;
        const float lr = fminf(C.in(9)[gp], -1e-4f), li = C.in(10)[gp], dt = expf(C.in(11)[l * 32 + g]);
        const float mag = expf(lr * dt); float sn, cs; sincosf(li * dt, &sn, &cs);
        const float ar = mag * cs, ai = mag * sn, den = lr * lr + li * li;
        const float fr = ((ar - 1.0f) * lr + ai * li) / den, fi = (ai * lr - (ar - 1.0f) * li) / den;
        C.AR[gtid] = ar; C.AI[gtid] = ai;
        const float* br = C.in(12) + (size_t)gp * 16; const float* bi = C.in(13) + (size_t)gp * 16;
        bf16* o_re = C.BBT + ((size_t)(g * 128 + p)) * 32; bf16* o_im = C.BBT + ((size_t)(g * 128 + 64 + p)) * 32;
        for (int c = 0; c < 16; ++c) { const float b_r = br[c], b_i = bi[c]; o_re[c] = (bf16)f2bf(fr * b_r - fi * b_i); o_im[c] = (bf16)f2bf(fr * b_i + fi * b_r); }
        { unsigned z = 0u; asm volatile("" : "+v"(z)); const u32x4 zz = {z, z, z, z};
          *(u32x4*)(o_re + 16) = zz; *(u32x4*)(o_re + 24) = zz; *(u32x4*)(o_im + 16) = zz; *(u32x4*)(o_im + 24) = zz; }
        for (int c = 0; c < 16; ++c) { const size_t ci = ((size_t)((l * 32 + g) * 16 + c)) * 64 + p;
            C.CM[((size_t)(g * 16 + c)) * 128 + p] = (bf16)f2bf(C.in(14)[ci]); C.CM[((size_t)(g * 16 + c)) * 128 + 64 + p] = (bf16)f2bf(-C.in(15)[ci]); }
    } else if (gtid < 2560) {
        const int d = gtid - 2048; const float a0 = C.in(19)[d], a1 = C.in(19)[512 + d], mx = fmaxf(a0, a1), e0 = expf(a0 - mx), e1 = expf(a1 - mx);
        const float p0 = e0 / (e0 + e1), p1 = e1 / (e0 + e1);
        C.LB[d] = (l == 0) ? (p0 - p0) : ((p0 + p1) - p0);
    }
}

__device__ __forceinline__ void rg1_load(const Ctx& C, int item, int tid, unsigned (&xw)[5]) {
    const int cidx = item >> 3, h = item & 7, t0 = cidx * 64, j = cidx & 63;
#pragma unroll
    for (int k = 0; k < 5; ++k) { const int i = tid + 512 * k, row = i >> 5, cp = i & 31; xw[k] = 0u;
        if (i < 67 * 32 && !(j == 0 && row < 3)) xw[k] = *(const unsigned*)(C.PROJ + (size_t)(t0 - 3 + row) * PW + XC_OFF + h * 64 + 2 * cp); }
}
__device__ __forceinline__ void rg1_item(const Ctx& C, unsigned char* lds, int l, int item, int tid, int wave, int lane, bool stage_w, unsigned (&xw)[5], int next_item) {
    const int cidx = item >> 3, h = item & 7, t0 = cidx * 64, j = cidx & 63, q = lane >> 4, r16 = lane & 15;
    float* XIN = (float*)lds; float* XCF = (float*)(lds + 17152); bf16* AT = (bf16*)(lds + 33536); bf16* BT = (bf16*)(lds + 42752); float* G = (float*)(lds + 61184);
    const int cc = tid & 63, chh = h * 64 + cc;
    { float bw[16];
      if (stage_w) { const int n = tid & 127; const float* wsrc = (n < 64 ? C.in(23) : C.in(25)) + ((size_t)((l * 8 + h) * 64)) * 64 + (n & 63);
#pragma unroll
        for (int k = 0; k < 16; ++k) bw[k] = wsrc[(size_t)((tid >> 7) + 4 * k) * 64];
#pragma unroll
        for (int k = 0; k < 16; ++k) BT[n * 72 + (tid >> 7) + 4 * k] = (bf16)f2bf(bw[k]); }
#pragma unroll
      for (int k = 0; k < 5; ++k) { const int i = tid + 512 * k, row = i >> 5, cp = i & 31; if (i < 67 * 32) { XIN[row * 64 + 2 * cp] = bf2f(xw[k] & 0xffffu); XIN[row * 64 + 2 * cp + 1] = bf2f(xw[k] >> 16); } } }
    const float cb_ = C.in(22)[l * 512 + chh], cw0 = C.in(21)[(l * 4 + 0) * 512 + chh], cw1 = C.in(21)[(l * 4 + 1) * 512 + chh], cw2 = C.in(21)[(l * 4 + 2) * 512 + chh], cw3 = C.in(21)[(l * 4 + 3) * 512 + chh];
    const float ba_ = C.in(24)[l * 512 + chh], bx_ = C.in(26)[l * 512 + chh];
    LBAR();
    if (next_item < 2048) rg1_load(C, next_item, tid, xw);
#pragma unroll
    for (int k = 0; k < 8; ++k) { const int t = (tid >> 6) + 8 * k, c = cc;
        const float xc = cb_ + cw0 * XIN[t * 64 + c] + cw1 * XIN[(t + 1) * 64 + c] + cw2 * XIN[(t + 2) * 64 + c] + cw3 * XIN[(t + 3) * 64 + c];
        XCF[t * 64 + c] = xc; AT[t * 72 + c] = (bf16)f2bf(xc); }
    LBAR();
    { bf16x8 bfr[2];
#pragma unroll
      for (int k = 0; k < 2; ++k) bfr[k] = *(const bf16x8*)(BT + (wave * 16 + r16) * 72 + k * 32 + q * 8);
#pragma unroll
      for (int tm = 0; tm < 4; ++tm) { f32x4 acc = {0.f, 0.f, 0.f, 0.f};
#pragma unroll
          for (int k = 0; k < 2; ++k) { const bf16x8 a = *(const bf16x8*)(AT + (tm * 16 + r16) * 72 + k * 32 + q * 8); acc = MFMA16(a, bfr[k], acc); }
#pragma unroll
          for (int jj = 0; jj < 4; ++jj) G[(tm * 16 + 4 * q + jj) * 129 + wave * 16 + r16] = acc[jj]; } }
    LBAR();
#pragma unroll
    for (int k = 0; k < 8; ++k) { const int t = (tid >> 6) + 8 * k, c = cc, ch = chh;
        const float r = sigm(G[t * 129 + c] + ba_), ig = sigm(G[t * 129 + 64 + c] + bx_);
        const unsigned rb = f2bf(r), ixb = f2bf(ig * XCF[t * 64 + c]);
        C.R[(size_t)(t0 + t) * 512 + ch] = (bf16)rb; C.IX[(size_t)(t0 + t) * 512 + ch] = (bf16)ixb;
        G[t * 129 + c] = bf2f(rb); G[t * 129 + 64 + c] = bf2f(ixb); }
    LBAR();
    { const int c = tid & 63, sg = tid >> 6, ch = h * 64 + c; const float sp8 = -8.0f * log1pf(expf(-C.in(27)[l * 512 + ch])); float A = 1.f, B = 0.f;
#pragma unroll
      for (int tt = 0; tt < 8; ++tt) { const int t = sg * 8 + tt; const float a = __expf(sp8 * G[t * 129 + c]), bb = __builtin_amdgcn_sqrtf(fmaxf(1.f - a * a, 0.f)) * G[t * 129 + 64 + c]; A *= a; B = a * B + bb; }
      XCF[(sg * 64 + c) * 2] = A; XCF[(sg * 64 + c) * 2 + 1] = B; }
    LBAR();
    if (tid < 64) { const int c = tid, ch = h * 64 + c; float A = 1.f, B = 0.f;
#pragma unroll
        for (int sg = 0; sg < 8; ++sg) { const float a = XCF[(sg * 64 + c) * 2], bb = XCF[(sg * 64 + c) * 2 + 1]; A *= a; B = a * B + bb; }
        f32x2 o; o.x = A; o.y = B; *(f32x2*)(C.AGG + ((size_t)cidx * 512 + ch) * 2) = o; }
    LBAR();
}
__device__ __forceinline__ void rgc_item(const Ctx& C, int l, int cidx, int tid) {
    const int b = cidx >> 6, j = cidx & 63, c = tid; float hst = 0.f;
    { const float* ag = C.AGG + ((size_t)(b * 64) * 512 + c) * 2;
      for (int i0 = 0; i0 < j; i0 += 16) {
          f32x2 ab[16];
#pragma unroll
          for (int k = 0; k < 16; ++k) ab[k] = *(const f32x2*)(ag + (size_t)(i0 + k) * 1024);
#pragma unroll
          for (int k = 0; k < 16; ++k) if (i0 + k < j) hst = ab[k].x * hst + ab[k].y; } }
    const float sp8 = -8.0f * log1pf(expf(-C.in(27)[l * 512 + c]));
    const bf16* rp = C.R + (size_t)cidx * 64 * 512 + c; const bf16* ip = C.IX + (size_t)cidx * 64 * 512 + c; bf16* gp = C.PROJ + (size_t)cidx * 64 * PW + GC_OFF + c;
#pragma unroll 32
    for (int t = 0; t < 64; ++t) {
        const float r = bf2f(rp[t * 512]), ix = bf2f(ip[t * 512]), gc = bf2f(gp[(size_t)t * PW]);
        const float a = __expf(sp8 * r), bb = __builtin_amdgcn_sqrtf(fmaxf(1.f - a * a, 0.f)) * ix;
        hst = a * hst + bb; gp[(size_t)t * PW] = (bf16)f2bf(hst * gc); }
}

template <bool FINAL>
__device__ __forceinline__ void s5_chunk(const Ctx& C, unsigned char* lds, int l, int item, int tid, int wave, int lane) {
    const int cidx = item >> 1, hf = item & 1, t0 = cidx * 128, q = lane >> 4, r16 = lane & 15, b = cidx >> 5, j = cidx & 31;
    bf16* UT = (bf16*)lds; float* BU = (float*)(lds + 34816) + wave * (16 * 132); bf16* XS = (bf16*)(lds + 34816 + 8 * 16 * 132 * 4) + wave * (16 * 136);
    u32x4 uw[4];
#pragma unroll
    for (int k = 0; k < 4; ++k) { const int i = tid + 512 * k, t = i >> 4, ck = i & 15; uw[k] = *(const u32x4*)(C.PROJ + (size_t)(t0 + t) * PW + UA_OFF + (2 * hf) * 128 + ck * 8); }
    for (int pp = 0; pp < 2; ++pp) {
        const int go = 2 * hf + pp, g = go * 8 + wave;
        f32x2 cs[32];
        if (FINAL) { const float* sl = C.SLOC + ((size_t)((b * 32) * 32 + g) * 64 + lane) * 2;
#pragma unroll
            for (int i = 0; i < 32; ++i) cs[i] = *(const f32x2*)(sl + (size_t)i * 4096); }
        float dsk[4];
        if (FINAL) {
#pragma unroll
            for (int jj = 0; jj < 4; ++jj) dsk[jj] = C.in(16)[l * 512 + g * 16 + 4 * q + jj]; }
        bf16x8 bfr[8];
#pragma unroll
        for (int tn = 0; tn < 8; ++tn) bfr[tn] = *(const bf16x8*)(C.BBT + ((size_t)(g * 128 + tn * 16 + r16)) * 32 + q * 8);
        const float ar = C.AR[g * 64 + lane], ai = C.AI[g * 64 + lane]; float xr = 0.f, xi = 0.f;
        bf16x8 cfr[4];
        if (FINAL) {
#pragma unroll
            for (int k = 0; k < 4; ++k) cfr[k] = *(const bf16x8*)(C.CM + ((size_t)(g * 16 + r16)) * 128 + k * 32 + q * 8); }
#pragma unroll
        for (int k = 0; k < 4; ++k) { const int i = tid + 512 * k, t = i >> 4, ck = i & 15; *(u32x4*)(UT + t * 136 + ck * 8) = uw[k]; }
        LBAR();
        if (FINAL) {
            float tr = ar, ti = ai;
#pragma unroll
            for (int s = 0; s < 7; ++s) { const float nr = tr * tr - ti * ti, ni = 2.f * tr * ti; tr = nr; ti = ni; }
#pragma unroll
            for (int i = 0; i < 32; ++i) if (i < j) { const float nr = tr * xr - ti * xi + cs[i].x, ni = tr * xi + ti * xr + cs[i].y; xr = nr; xi = ni; }
        }
        if (pp == 0) {
#pragma unroll
            for (int k = 0; k < 4; ++k) { const int i = tid + 512 * k, t = i >> 4, ck = i & 15; uw[k] = *(const u32x4*)(C.PROJ + (size_t)(t0 + t) * PW + UA_OFF + (go + 1) * 128 + ck * 8); }
        }
        for (int tm = 0; tm < 8; ++tm) {
            bf16x8 af = {0, 0, 0, 0, 0, 0, 0, 0}; if (q < 2) af = *(const bf16x8*)(UT + (tm * 16 + r16) * 136 + wave * 16 + q * 8);
#pragma unroll
            for (int tn = 0; tn < 8; ++tn) { f32x4 acc = {0.f, 0.f, 0.f, 0.f}; acc = MFMA16(af, bfr[tn], acc);
#pragma unroll
                for (int jj = 0; jj < 4; ++jj) BU[(4 * q + jj) * 132 + tn * 16 + r16] = acc[jj]; }
            LBAR();
#pragma unroll
            for (int tt = 0; tt < 16; ++tt) { const float bur = BU[tt * 132 + lane], bui = BU[tt * 132 + 64 + lane];
                const float nr = ar * xr - ai * xi + bur, ni = ar * xi + ai * xr + bui; xr = nr; xi = ni;
                if (FINAL) { XS[tt * 136 + lane] = (bf16)f2bf(xr); XS[tt * 136 + 64 + lane] = (bf16)f2bf(xi); } }
            LBAR();
            if (FINAL) {
                f32x4 acc = {0.f, 0.f, 0.f, 0.f};
#pragma unroll
                for (int k = 0; k < 4; ++k) { const bf16x8 xb = *(const bf16x8*)(XS + r16 * 136 + k * 32 + q * 8); acc = MFMA16(cfr[k], xb, acc); }
                const int t = tm * 16 + r16; const bf16* up = UT + t * 136 + wave * 16 + 4 * q; float v[4];
#pragma unroll
                for (int jj = 0; jj < 4; ++jj) v[jj] = gelu_(acc[jj] + dsk[jj] * bf2f(up[jj]));
                u32x2 o; o.x = pk2(v[0], v[1]); o.y = pk2(v[2], v[3]); *(u32x2*)(C.PROJ + (size_t)(t0 + t) * PW + UA_OFF + g * 16 + 4 * q) = o;
            }
        }
        if (!FINAL) { f32x2 o; o.x = xr; o.y = xi; *(f32x2*)(C.SLOC + ((size_t)(cidx * 32 + g) * 64 + lane) * 2) = o; }
        LBAR();
    }
}

__device__ __forceinline__ void hg_stage(const Ctx& C, unsigned char* lds, int t0, int h, int tid, float (&lfr)[16], float (&bcv)[16]) {
    float* BC = (float*)lds; bf16* VT = (bf16*)(lds + 33024); float* TOT = (float*)(lds + 33024 + 18432);
    { const int d = tid & 127, qt = tid >> 7; const bf16* p = C.PROJ + (size_t)(t0 + qt * 16) * PW + F_OFF + h * 128 + d; float loc[16]; float run = 0.f;
#pragma unroll
      for (int i = 0; i < 16; ++i) { loc[i] = bf2f(p[(size_t)i * PW]); lfr[i] = loc[i]; }
#pragma unroll
      for (int i = 0; i < 16; ++i) { run += loc[i]; loc[i] = run; }
      TOT[qt * 128 + d] = run;
      unsigned vw[8];
#pragma unroll
      for (int k = 0; k < 8; ++k) { const int i = tid + 512 * k, s = i >> 6, ep = i & 63; vw[k] = *(const unsigned*)(C.PROJ + (size_t)(t0 + s) * PW + V_OFF + h * 128 + 2 * ep); }
#pragma unroll
      for (int k = 0; k < 8; ++k) { const int i = tid + 512 * k, s = i >> 6, ep = i & 63; VT[(2 * ep) * 72 + s] = (bf16)(vw[k] & 0xffffu); VT[(2 * ep + 1) * 72 + s] = (bf16)(vw[k] >> 16); }
      LBAR();
      float off = 0.f;
      for (int qq = 0; qq < qt; ++qq) off += TOT[qq * 128 + d];
#pragma unroll
      for (int i = 0; i < 16; ++i) { bcv[i] = loc[i] + off; BC[(qt * 16 + i) * 128 + d] = bcv[i]; } }
    LBAR();
}
__device__ __forceinline__ void hg1_item(const Ctx& C, unsigned char* lds, int item, int tid, int wave, int lane) {
    const int cidx = item >> 2, h = item & 3, t0 = cidx * 64, q = lane >> 4, r16 = lane & 15;
    float* BC = (float*)lds; bf16* VT = (bf16*)(lds + 33024); bf16* KT = (bf16*)(lds + 33024 + 18432);
    float lfr[16], bcv[16];
    hg_stage(C, lds, t0, h, tid, lfr, bcv);
    { const int d = tid & 127, qt = tid >> 7; const float bl = BC[63 * 128 + d];
#pragma unroll
      for (int i = 0; i < 16; ++i) { const int s = qt * 16 + i; const float kh = (1.f - __expf(lfr[i])) * __expf(bl - bcv[i]); KT[d * 72 + s] = (bf16)f2bf(kh); }
      if (qt == 3) C.DEC[(size_t)item * 128 + d] = __expf(bl); }
    LBAR();
    bf16x8 vf[2];
#pragma unroll
    for (int k = 0; k < 2; ++k) vf[k] = *(const bf16x8*)(VT + (wave * 16 + r16) * 72 + k * 32 + q * 8);
#pragma unroll
    for (int tm = 0; tm < 8; ++tm) { f32x4 acc = {0.f, 0.f, 0.f, 0.f};
#pragma unroll
        for (int k = 0; k < 2; ++k) { const bf16x8 kf = *(const bf16x8*)(KT + (tm * 16 + r16) * 72 + k * 32 + q * 8); acc = MFMA16(kf, vf[k], acc); }
        u32x2 o; o.x = pk2(acc[0], acc[1]); o.y = pk2(acc[2], acc[3]);
        *(u32x2*)(C.HGS + ((size_t)item * 128 + wave * 16 + r16) * 128 + tm * 16 + 4 * q) = o; }
    LBAR();
}
__device__ __forceinline__ void hg2_elem(const Ctx& C, int idx) {
    const int dp = idx & 63, e = (idx >> 6) & 127, h = (idx >> 13) & 3, b = idx >> 15; float s0 = 0.f, s1 = 0.f;
#pragma unroll 32
    for (int j = 0; j < 64; ++j) { const size_t item = (size_t)(b * 64 + j) * 4 + h; unsigned* p = (unsigned*)(C.HGS + (item * 128 + e) * 128 + 2 * dp);
        const f32x2 dc = *(const f32x2*)(C.DEC + item * 128 + 2 * dp); const unsigned w = *p; *p = pk2(s0, s1);
        s0 = dc.x * s0 + bf2f(w & 0xffffu); s1 = dc.y * s1 + bf2f(w >> 16); }
}
__device__ __forceinline__ void hg3_item(const Ctx& C, unsigned char* lds, int l, int item, int tid, int wave, int lane) {
    const int cidx = item >> 2, h = item & 3, t0 = cidx * 64, q = lane >> 4, r16 = lane & 15;
    float* BC = (float*)lds; float* OF = (float*)lds; bf16* VT = (bf16*)(lds + 33024); bf16* QB = (bf16*)(lds + 51456); bf16* QT = (bf16*)(lds + 68864);
    bf16* K0 = (bf16*)(lds + 86272); bf16* K1 = (bf16*)(lds + 94976); bf16* P = (bf16*)(lds + 112384);
    bf16x8 sf[4];
#pragma unroll
    for (int k = 0; k < 4; ++k) sf[k] = *(const bf16x8*)(C.HGS + ((size_t)item * 128 + wave * 16 + r16) * 128 + k * 32 + q * 8);
    float qv_[16], lfr[16], bcv[16];
    { const int d = tid & 127, qt = tid >> 7; const bf16* pr = C.PROJ + (size_t)(t0 + qt * 16) * PW + Q_OFF + h * 128 + d;
#pragma unroll
      for (int i = 0; i < 16; ++i) qv_[i] = bf2f(pr[(size_t)i * PW]); }
    hg_stage(C, lds, t0, h, tid, lfr, bcv);
    { const int d = tid & 127, qt = tid >> 7; const float r1 = BC[31 * 128 + d];
#pragma unroll
      for (int i = 0; i < 16; ++i) { const int t = qt * 16 + i;
        const float qv = qv_[i], bt = bcv[i], kv = (1.f - __expf(lfr[i]));
        QB[t * 136 + d] = (bf16)f2bf(qv * __expf(bt)); QT[t * 136 + d] = (bf16)f2bf(qv * __expf(bt - (qt >= 2 ? r1 : 0.f)));
        if (qt < 2) K0[t * 136 + d] = (bf16)f2bf(kv * __expf(fminf(-bt, 80.f)));
        K1[t * 136 + d] = (bf16)f2bf(kv * __expf(fminf(r1 - bt, 80.f))); } }
    for (int i = tid; i < 1024; i += 512) P[(i >> 5) * 72 + 32 + (i & 31)] = 0;
    LBAR();
    for (int tile = wave; tile < 12; tile += 8) { int tm, tn; const bf16* KB;
        if (tile < 4) { tm = tile >> 1; tn = tile & 1; KB = K0; } else { const int tt = tile - 4; tm = 2 + (tt >> 2); tn = tt & 3; KB = K1; }
        f32x4 acc = {0.f, 0.f, 0.f, 0.f};
#pragma unroll
        for (int k = 0; k < 4; ++k) { const bf16x8 a = *(const bf16x8*)(QT + (tm * 16 + r16) * 136 + k * 32 + q * 8); const bf16x8 bb = *(const bf16x8*)(KB + (tn * 16 + r16) * 136 + k * 32 + q * 8); acc = MFMA16(a, bb, acc); }
        const int s = tn * 16 + r16;
#pragma unroll
        for (int jj = 0; jj < 4; ++jj) { const int t = tm * 16 + 4 * q + jj; P[t * 72 + s] = (s <= t) ? (bf16)f2bf(acc[jj]) : (bf16)0; } }
    LBAR();
    { bf16x8 vf[2];
#pragma unroll
      for (int k = 0; k < 2; ++k) vf[k] = *(const bf16x8*)(VT + (wave * 16 + r16) * 72 + k * 32 + q * 8);
#pragma unroll
      for (int tm = 0; tm < 4; ++tm) { f32x4 acc = {0.f, 0.f, 0.f, 0.f};
#pragma unroll
          for (int k = 0; k < 4; ++k) { const bf16x8 a = *(const bf16x8*)(QB + (tm * 16 + r16) * 136 + k * 32 + q * 8); acc = MFMA16(a, sf[k], acc); }
#pragma unroll
          for (int k = 0; k < 2; ++k) { const bf16x8 a = *(const bf16x8*)(P + (tm * 16 + r16) * 72 + k * 32 + q * 8); acc = MFMA16(a, vf[k], acc); }
#pragma unroll
          for (int jj = 0; jj < 4; ++jj) OF[(tm * 16 + 4 * q + jj) * 129 + wave * 16 + r16] = acc[jj]; } }
    LBAR();
    { const int t = tid >> 3, e0 = (tid & 7) * 16; float o[16], ss = 0.f;
#pragma unroll
      for (int i = 0; i < 16; ++i) { o[i] = OF[t * 129 + e0 + i]; ss += o[i] * o[i]; }
      ss += __shfl_xor(ss, 1); ss += __shfl_xor(ss, 2); ss += __shfl_xor(ss, 4);
      const float rstd = __builtin_amdgcn_rsqf(ss * (1.f / 128.f) + 1e-6f);
      bf16* row = C.PROJ + (size_t)(t0 + t) * PW + h * 128 + e0; const float* nw = C.in(20) + l * 512 + h * 128 + e0;
#pragma unroll
      for (int hf = 0; hf < 2; ++hf) { float gg[8], v[8]; load8(row + G_OFF + hf * 8, gg);
#pragma unroll
          for (int i = 0; i < 8; ++i) v[i] = o[hf * 8 + i] * rstd * nw[hf * 8 + i] * gg[i];
          store8(row + Q_OFF + hf * 8, v); } }
    LBAR();
}

#define LAS __attribute__((address_space(3)))
#define XB_TMO      128
#define XB_XCNT(j)  (256  + 64 * (j))
#define XB_XSUB(j)  (1280 + 64 * (j))
#define XB_XGEN(j)  (2304 + 64 * (j))
#define XB_TOP      3328
#define XB_TOPGEN   3392
#define XCD_BAR_WORDS 3456
#define XB_SPIN_CAP (1u << 18)

__device__ __forceinline__ unsigned xb_ld(unsigned* p)              { return __hip_atomic_load(p, __ATOMIC_RELAXED, __HIP_MEMORY_SCOPE_AGENT); }
__device__ __forceinline__ unsigned xb_add(unsigned* p, unsigned v) { return __hip_atomic_fetch_add(p, v, __ATOMIC_RELAXED, __HIP_MEMORY_SCOPE_AGENT); }
__device__ __forceinline__ unsigned xb_xcc_id() { return (unsigned)__builtin_amdgcn_s_getreg((3 << 11) | 20) & 0xFu; }
#define XB_SPIN(cond, bar) do { unsigned _sp = 0; while (cond) { __builtin_amdgcn_s_sleep(1); \
    if ((++_sp & 255u) == 0u) { if (xb_ld(&(bar)[XB_TMO])) break; if (_sp > XB_SPIN_CAP) { atomicAdd(&(bar)[XB_TMO], 1u); break; } } } } while (0)

struct XcdBarrier {
    unsigned* bar; unsigned x;
    volatile LAS unsigned* st;
};

__device__ __forceinline__ XcdBarrier xcd_barrier_post(unsigned* bar, volatile LAS unsigned* st) {
    XcdBarrier b; b.bar = bar; b.x = xb_xcc_id(); b.st = st;
    if (threadIdx.x == 0) (void)xb_add(&bar[XB_XCNT(b.x)], 1u);
    return b;
}
__device__ __forceinline__ void xcd_barrier_complete(unsigned* bar, unsigned x, unsigned& nloc, unsigned& nx) {
    const unsigned G = gridDim.x * gridDim.y * gridDim.z;
    unsigned sum, cnt, mine, sp = 0u;
    for (;;) {
        sum = 0u; cnt = 0u; mine = 0u;
#pragma unroll
        for (unsigned j = 0; j < 16; ++j) { const unsigned c = xb_ld(&bar[XB_XCNT(j)]); sum += c; cnt += (c > 0u) ? 1u : 0u; mine = (j == x) ? c : mine; }
        if (sum == G) break;
        __builtin_amdgcn_s_sleep(1);
        if ((++sp & 255u) == 0u) { if (xb_ld(&bar[XB_TMO])) break; if (sp > XB_SPIN_CAP) { atomicAdd(&bar[XB_TMO], 1u); break; } }
    }
    nloc = mine > 0u ? mine : 1u; nx = cnt > 0u ? cnt : 1u;
}

__device__ __forceinline__ void xcd_barrier(const XcdBarrier& b) {
    asm volatile("s_waitcnt vmcnt(0)" ::: "memory");
    __syncthreads();
    if (threadIdx.x == 0) {
        unsigned* bar = b.bar;
        __builtin_amdgcn_s_waitcnt(0);
        unsigned nloc = b.st[0], nx = b.st[1];
        if (nloc == 0u) { xcd_barrier_complete(bar, b.x, nloc, nx); b.st[0] = nloc; b.st[1] = nx; }
        const unsigned old = xb_add(&bar[XB_XSUB(b.x)], 1u);
        const unsigned gen = old / nloc;
        if (old + 1u == (gen + 1u) * nloc) {
            __builtin_amdgcn_fence(__ATOMIC_RELEASE, "agent");
            asm volatile("s_waitcnt vmcnt(0)" ::: "memory");
            const unsigned og = xb_add(&bar[XB_TOP], 1u);
            const unsigned tg = og / nx;
            if (og + 1u == (tg + 1u) * nx) xb_add(&bar[XB_TOPGEN], 1u);
            else XB_SPIN(xb_ld(&bar[XB_TOPGEN]) == tg, bar);
            __builtin_amdgcn_fence(__ATOMIC_ACQUIRE, "agent");
            xb_add(&bar[XB_XGEN(b.x)], 1u);
            asm volatile("s_waitcnt vmcnt(0)" ::: "memory");
        } else {
            XB_SPIN(xb_ld(&bar[XB_XGEN(b.x)]) == gen, bar);
            __builtin_amdgcn_fence(__ATOMIC_ACQUIRE, "agent");
            asm volatile("s_waitcnt vmcnt(0)" ::: "memory");
        }
    }
    __syncthreads();
}

__device__ __forceinline__ void team_sync(unsigned* word, int tid, int same_xcd) {
    asm volatile("s_waitcnt vmcnt(0)" ::: "memory");
    __syncthreads();
    if (tid == 0) {
        if (!same_xcd) { __builtin_amdgcn_fence(__ATOMIC_RELEASE, "agent"); asm volatile("s_waitcnt vmcnt(0)" ::: "memory"); }
        (void)xb_add(word, 1u);
        unsigned sp = 0u;
        while (xb_ld(word) < 4u) { __builtin_amdgcn_s_sleep(1); if (++sp > (1u << 22)) break; }
        __builtin_amdgcn_fence(__ATOMIC_ACQUIRE, "agent");
        asm volatile("s_waitcnt vmcnt(0)" ::: "memory");
    }
    __syncthreads();
}

struct Args { const float* in[28]; float* out; unsigned char* ws; int ph_lo, ph_hi; };
__global__ void __launch_bounds__(512, 2) fwd_megakernel(Args args) {
    extern __shared__ __attribute__((aligned(16))) unsigned char lds[];
    cg::grid_group grid = cg::this_grid();
    PG8_LAS unsigned char* ldsl = (PG8_LAS unsigned char*)lds;
    if (threadIdx.x < 16) ((volatile LAS unsigned*)(ldsl + LDS_PHASE))[threadIdx.x] = 0u;
    __syncthreads();
    int team_same = 0;
    XcdBarrier xbar = xcd_barrier_post((unsigned*)(args.ws + WS_BAR), (volatile LAS unsigned*)(ldsl + LDS_PHASE));
    if (threadIdx.x == 0) __hip_atomic_store((unsigned*)(args.ws + WS_TEAMX) + blockIdx.x, xbar.x + 1u, __ATOMIC_RELAXED, __HIP_MEMORY_SCOPE_AGENT);
    if (args.ph_hi > 1000) grid.sync();
    for (int ph = args.ph_lo; ph < args.ph_hi; ++ph) {
        if (gridDim.x == 256 && (ph == NPH - 1 || (ph % 14) == 3)) continue;
        if (ph == args.ph_lo + 1) xcd_barrier(xbar);
        else if (ph > args.ph_lo + 1) {
            const int sp_ = (ph - 1) % 14, lp_ = (ph - 1) / 14;
            if (ph == args.ph_lo + 2 && gridDim.x == 256) {
                const unsigned* tx = (const unsigned*)(args.ws + WS_TEAMX); const int c0 = blockIdx.x & 63; unsigned same = 1u;
                const unsigned me = xb_ld((unsigned*)tx + blockIdx.x);
#pragma unroll
                for (int k = 0; k < 4; ++k) same &= (xb_ld((unsigned*)tx + c0 + 64 * k) == me) ? 1u : 0u;
                team_same = __builtin_amdgcn_readfirstlane((int)(same & (me != 0u ? 1u : 0u)));
            }
            if (gridDim.x == 256 && (sp_ == 2 || sp_ == 3 || sp_ == 8 || sp_ == 9 || sp_ == 13)) {
                const int c_ = blockIdx.x, pm_ = 8 * (c_ & 7) + ((c_ >> 3) & 7);
                team_sync((unsigned*)(args.ws + WS_TEAM) + (size_t)(ph * 64 + pm_) * 64, threadIdx.x, team_same);
            } else xcd_barrier(xbar);
        }
        int tid = threadIdx.x; asm volatile("" : "+v"(tid));
        int bid = blockIdx.x, G = gridDim.x; asm volatile("" : "+s"(bid), "+s"(G));
        __attribute__((address_space(1))) unsigned char* wsg = (__attribute__((address_space(1))) unsigned char*)args.ws; asm volatile("" : "+s"(wsg)); unsigned char* ws = (unsigned char*)wsg;
        Ctx C;
        { KArgP kb = (KArgP)__builtin_amdgcn_kernarg_segment_ptr(); asm volatile("" : "+s"(kb)); C.kin = kb; }
        C.X = args.out; C.ws = ws;
        C.LB = (float*)(ws + WS_LB); C.AR = (float*)(ws + WS_AR); C.AI = (float*)(ws + WS_AI); C.DEC = (float*)(ws + WS_DEC); C.AGG = (float*)(ws + WS_AGG); C.SLOC = (float*)(ws + WS_SLOC);
        C.BBT = (bf16*)(ws + WS_BBT); C.CM = (bf16*)(ws + WS_CM); C.W = (bf16*)(ws + WS_W); C.HB = (bf16*)(ws + WS_HB); C.PROJ = (bf16*)(ws + WS_PROJ);
        C.R = (bf16*)(ws + WS_R); C.IX = (bf16*)(ws + WS_IX); C.HGS = (bf16*)(ws + WS_HGS); C.GM = (bf16*)(ws + WS_GM);
        const int lane = tid & 63, wave = __builtin_amdgcn_readfirstlane(tid >> 6);
        const int gw = bid * 8 + wave, NGW = G * 8, gtid = bid * 512 + tid;
        float* scr = (float*)(lds + wave * 16384);
        const bool team_ = (G == 256);
        const int prow_ = (8 * (bid & 7) + ((bid >> 3) & 7)) * 256 + (bid >> 6) * 64 + wave * 8;
        if (ph == NPH - 1) { if (team_) final_norm_rows(C.X, C.in(2), prow_, 1, prow_ + 8, lane); else final_norm_rows(C.X, C.in(2), gw, NGW, NTOK, lane); continue; }
        const int l = ph / 14, s = ph % 14;
        int ngemm = 0;
        if (s == 0 || s == 11) {
            const int j = (s == 0) ? 0 : 1;
            if (team_ && !(s == 0 && l == 0)) { }
            else norm_rows((l == 0 && s == 0) ? C.in(0) : C.X, nullptr, C.in(1) + (l * 3 + (j ? 2 : 0)) * DM, C.HB, gw, NGW, NTOK, lane);
            convert_ffn(C, l, j, scr, gw, NGW, lane, 0);
        } else if (s == 3) {
            if (!team_) norm_rows(C.X, nullptr, C.in(1) + (l * 3 + 1) * DM, C.HB, gw, NGW, NTOK, lane);
            if (!team_) { convert_mixer(C, l, scr, gw, NGW, lane, 0); make_tables(C, l, gtid); }
        } else if (s == 5) {
            { unsigned xw[5]; if (bid < 2048) rg1_load(C, bid, tid, xw);
              for (int it = bid; it < 2048; it += G) rg1_item(C, lds, l, it, tid, wave, lane, it == bid || (G & 7) != 0, xw, it + G); }
            for (int it = bid; it < 256; it += G) s5_chunk<false>(C, lds, l, it, tid, wave, lane);
            for (int it = bid; it < 1024; it += G) hg1_item(C, lds, it, tid, wave, lane);
        } else if (s == 6) {
            for (int it = bid; it < 256; it += G) rgc_item(C, l, it, tid);
            for (int idx = gtid; idx < 131072; idx += G * 512) hg2_elem(C, idx);
            for (int it = bid; it < 256; it += G) s5_chunk<true>(C, lds, l, it, tid, wave, lane);
        } else if (s == 7) {
            if (G == 256) { const int nit = (bid < 128) ? 3 : 5, base = (bid < 128) ? bid * 3 : 384 + (bid - 128) * 5;
                for (int k = 0; k < nit; ++k) hg3_item(C, lds, l, base + k, tid, wave, lane); }
            else for (int it = bid; it < 1024; it += G) hg3_item(C, lds, l, it, tid, wave, lane);
            ngemm = 1;
        }
        else ngemm = 1;
        for (int gi = 0; gi < ngemm; ++gi) {
            pg8::Gemm g; int nseg = 1; Epi E; E.mode = 0; E.O = nullptr; E.ldc = 0; E.X = C.X; E.Xsrc = (l == 0 && s == 2) ? C.in(0) : C.X; E.scale = 1.f; E.aux = nullptr; E.ldaux = 0; E.vec = nullptr; E.first = 0; E.ssq = (float*)(ws + WS_SSQ); E.tword = (unsigned*)(ws + WS_TEAM) + (size_t)((29 + ph) * 64 + (8 * (bid & 7) + ((bid >> 3) & 7))) * 64; E.same = team_same;
            if (s == 1 || s == 12) { g = pg8::Gemm{C.HB, C.W + W_GU, NTOK, 2 * DFF, DM, DM, 0, 0, 0, 0}; E.mode = 0; E.O = (bf16*)(ws + WS_ACT); E.ldc = DFF; }
            else if (s == 2 || s == 13) { g = pg8::Gemm{(bf16*)(ws + WS_ACT), C.W + W_D, NTOK, DM, DFF, DFF, 0, 0, 0, 0}; E.mode = 1; E.scale = 0.5f;
                if (team_) { if (l == 1 && s == 13) { E.mode = 6; E.vec = C.in(2); }
                    else { E.mode = 7; E.O = C.HB; E.vec = C.in(1) + ((s == 2) ? (l * 3 + 1) : ((l + 1) * 3)) * DM; } } }
            else if (s == 4) { g = pg8::Gemm{C.HB, (bf16*)(ws + WS_WI0), NTOK, PW, DM, DM, 0, 0, 0, 0}; E.mode = 2; E.O = C.PROJ; E.ldc = PW; E.vec = C.LB; }
            else if (s == 7) { g = pg8::Gemm{C.PROJ + UA_OFF, C.W + W_GLU, NTOK, 512, 512, PW, 0, 0, 0, 0}; E.mode = 3; E.O = C.PROJ + XC_OFF; E.ldc = PW; E.aux = C.PROJ + UA_OFF; E.ldaux = PW; E.vec = C.in(18) + l * 512; }
            else if (s == 8) { g = pg8::Gemm{C.HB, C.W + W_GMW, NTOK, GMW, DM, DM, 0, 0, 0, 0}; E.mode = 4; E.O = C.GM; E.ldc = GMW; }
            else if (s == 9) { g = pg8::Gemm{C.PROJ, C.W + W_BP, NTOK, DM, 512, PW, XC_OFF * 2, Q_OFF * 2, GC_OFF * 2, DM * 512 * 2};
                E.mode = 5; E.O = C.HB; E.ldc = DM; E.aux = C.GM; E.ldaux = GMW; nseg = 3; }
            else { g = pg8::Gemm{C.HB, C.W + W_WO, NTOK, DM, DM, DM, 0, 0, 0, 0}; E.mode = 1; E.scale = 1.f;
                if (team_) { E.mode = 7; E.O = C.HB; E.vec = C.in(1) + (l * 3 + 2) * DM; } }
            pg8::StaticOrder S; S.init(g.M, g.N, G, bid, nseg);
            pg8::gemm_phase<Epi, pg8::StaticOrder, true, true>(ldsl, g, S, E, tid);
            __syncthreads();
        }
        if (s == 1 || s == 12 || s == 4) {
            int tid2 = threadIdx.x, bid2 = blockIdx.x, G2 = gridDim.x; asm volatile("" : "+v"(tid2)); asm volatile("" : "+s"(bid2), "+s"(G2));
            if (bid2 >= (G2 >> 1)) { const int wv2 = __builtin_amdgcn_readfirstlane(tid2 >> 6), hw = (bid2 - (G2 >> 1)) * 8 + wv2, HNW = (G2 - (G2 >> 1)) * 8; float* scr2 = (float*)(lds + wv2 * 16384);
                if (s == 4) convert_mixer(C, l, scr2, hw, HNW, tid2 & 63, 1); else convert_ffn(C, l, s == 1 ? 0 : 1, scr2, hw, HNW, tid2 & 63, 1);
                if (s == 1 && G2 == 256) { convert_mixer(C, l, scr2, hw, HNW, tid2 & 63, 0); make_tables(C, l, (bid2 - (G2 >> 1)) * 512 + tid2); } }
        }
    }
}

extern "C" void kernel_launch(void* const* d_in, const int* in_sizes, int n_in, void* d_out, int out_size, void* d_ws, size_t ws_size, hipStream_t stream) {
    static int grid = 0;
    if (grid == 0) {
        if (n_in != 28 || out_size != NTOK * DM || ws_size < WS_END) { fprintf(stderr, "kernel_launch: unexpected shapes (n_in %d out %d ws %zu)\n", n_in, out_size, ws_size); grid = -1; return; }
        int dev = 0, cus = 0, per_cu = 0;
        hipGetDevice(&dev); hipDeviceGetAttribute(&cus, hipDeviceAttributeMultiprocessorCount, dev);
        hipFuncSetAttribute((const void*)fwd_megakernel, hipFuncAttributeMaxDynamicSharedMemorySize, LDS_BYTES);
        hipOccupancyMaxActiveBlocksPerMultiprocessor(&per_cu, (const void*)fwd_megakernel, 512, LDS_BYTES);
        if (per_cu < 1 || cus < 1) { fprintf(stderr, "kernel_launch: occupancy query says %d blocks per CU (%d CUs)\n", per_cu, cus); grid = -1; return; }
        grid = cus;
    }
    if (grid < 0) return;
    if (hipMemsetAsync((char*)d_ws + WS_TEAM, 0, CTL_BYTES, stream) != hipSuccess) { fprintf(stderr, "kernel_launch: hipMemsetAsync of the control words failed\n"); return; }
    Args a{};
    for (int i = 0; i < 28; ++i) a.in[i] = (const float*)d_in[i];
    a.out = (float*)d_out; a.ws = (unsigned char*)d_ws; a.ph_lo = 0; a.ph_hi = NPH;
    void* kargs[] = {&a};
    hipError_t e = hipLaunchCooperativeKernel((const void*)fwd_megakernel, dim3(grid), dim3(512), kargs, LDS_BYTES, stream);
    if (e != hipSuccess) fprintf(stderr, "cooperative launch failed: %s (grid %d)\n", hipGetErrorString(e), grid);
}
```
